# Optimizing an MI355X kernel written in HIP

```python
import math
import jax, jax.numpy as jnp
from jax import lax
import numpy as np

D_MODEL = 1024
BATCH = 16
SEQ = 2048
DEPTH = 1

HEAD_DIM = 64
N_HEADS_A = D_MODEL // (2 * HEAD_DIM)
N_HEADS_B = D_MODEL // (2 * HEAD_DIM)
WIDTH_A = N_HEADS_A * HEAD_DIM
WIDTH_B = N_HEADS_B * HEAD_DIM
MIX_WIDTH = WIDTH_A + WIDTH_B
N_IDX_HEADS = 8
IDX_DIM = 64
TOPK_MAX = 256
D_FF = 2816
N_BUCKETS = 32
MAX_DISTANCE = 128
SPARSE_BLOCK = 32
SB_BLOCK = 128
N_SUBLAYERS = 3
N_MOD = 3 * N_SUBLAYERS
EPS = 1e-6

IN_SIZES = [WIDTH_A, WIDTH_A, WIDTH_A, N_IDX_HEADS * IDX_DIM, IDX_DIM, N_IDX_HEADS,
            WIDTH_B, WIDTH_B, WIDTH_B]
IN_COLS = sum(IN_SIZES)
IN_SPLITS = list(np.cumsum(IN_SIZES)[:-1])

kernel_name = "hybrid_dsa_stickbreaking_macaron_block"


def rmsnorm(x, g):
    xf = x.astype(jnp.float32)
    y = xf * lax.rsqrt(jnp.mean(xf * xf, axis=-1, keepdims=True) + EPS)
    return (y * g.astype(jnp.float32)).astype(x.dtype)


def modulate(x, shift, scale):
    return x * (1 + scale[:, None, :]) + shift[:, None, :]


def swiglu(x, w_gate, w_up, w_down):
    return (jax.nn.silu(x @ w_gate) * (x @ w_up)) @ w_down


def t5_bucket(n):
    n = jnp.maximum(n, 0)
    max_exact = N_BUCKETS // 2
    nf = jnp.maximum(n, 1).astype(jnp.float32)
    large = max_exact + (jnp.log(nf / max_exact) / math.log(MAX_DISTANCE / max_exact)
                         * (N_BUCKETS - max_exact)).astype(jnp.int32)
    large = jnp.minimum(large, N_BUCKETS - 1)
    return jnp.where(n < max_exact, n, large)


def dsa_sparse_attention(q, k, v, q_idx, k_idx, w_idx, rel_bias):
    B, S, H, D = q.shape
    topk = min(TOPK_MAX, S // 4)
    nb = S // SPARSE_BLOCK
    key_pos = jnp.arange(S)

    def blocks(a):
        return jnp.swapaxes(a.reshape(B, nb, SPARSE_BLOCK, *a.shape[2:]), 0, 1)

    def one(args):
        qb, qib, wb, t0 = args
        tpos = t0 + jnp.arange(SPARSE_BLOCK)
        sc = jax.nn.relu(jnp.einsum('bthd,bsd->bths', qib, k_idx).astype(jnp.float32))
        score = jnp.einsum('bths,bth->bts', sc, wb.astype(jnp.float32))
        causal = key_pos[None, :] <= tpos[:, None]
        score = jnp.where(causal[None], score, -jnp.inf)
        _, idx = lax.top_k(score, topk)
        kg = jax.vmap(lambda kk, ii: kk[ii])(k, idx)
        vg = jax.vmap(lambda vv, ii: vv[ii])(v, idx)
        dist = tpos[None, :, None] - idx
        valid = dist >= 0
        bias = jnp.swapaxes(rel_bias[t5_bucket(dist)], -1, -2)
        logits = (jnp.einsum('bthd,btkhd->bthk', qb, kg).astype(jnp.float32) * (D ** -0.5)
                  + bias.astype(jnp.float32))
        logits = jnp.where(valid[:, :, None, :], logits, -jnp.inf)
        p = jax.nn.softmax(logits, axis=-1)
        return jnp.einsum('bthk,btkhd->bthd', p.astype(v.dtype), vg)

    starts = jnp.arange(nb) * SPARSE_BLOCK
    out = lax.map(one, (blocks(q), blocks(q_idx), blocks(w_idx), starts))
    return jnp.swapaxes(out, 0, 1).reshape(B, S, H * D)


def stick_breaking_attention(q, k, v):
    B, S, H, D = q.shape
    nb = S // SB_BLOCK
    key_pos = jnp.arange(S)
    q_blocks = jnp.swapaxes(q.reshape(B, nb, SB_BLOCK, H, D), 0, 1)

    def one(args):
        qb, t0 = args
        tpos = t0 + jnp.arange(SB_BLOCK)
        z = jnp.einsum('bthd,bshd->bhts', qb, k).astype(jnp.float32) * (D ** -0.5)
        mask = (key_pos[None, :] < tpos[:, None])[None, None]
        u = jnp.where(mask, jax.nn.log_sigmoid(-z), 0.0)
        between = lax.cumsum(u, axis=3, reverse=True) - u
        a = jnp.where(mask, jnp.exp(jax.nn.log_sigmoid(z) + between), 0.0)
        return jnp.einsum('bhts,bshd->bthd', a.astype(v.dtype), v)

    starts = jnp.arange(nb) * SB_BLOCK
    out = lax.map(one, (q_blocks, starts))
    return jnp.swapaxes(out, 0, 1).reshape(B, S, H * D)


def setup_inputs(seed: int = 0) -> dict:
    key = jax.random.key(seed)
    ks = jax.random.split(key, 20)
    f32 = jnp.float32
    nrm = lambda k, shape, s: jax.random.normal(k, shape, f32) * s
    return {
        "x": nrm(ks[0], (BATCH, SEQ, D_MODEL), 1.0),
        "c": nrm(ks[1], (BATCH, D_MODEL), 1.0),
        "w_ada": nrm(ks[2], (DEPTH, D_MODEL, N_MOD * D_MODEL), 0.5 * D_MODEL ** -0.5),
        "b_ada": nrm(ks[3], (DEPTH, N_MOD * D_MODEL), 0.02),
        "g_pre": 1.0 + nrm(ks[4], (DEPTH, N_SUBLAYERS, D_MODEL), 0.05),
        "g_post": 1.0 + nrm(ks[5], (DEPTH, N_SUBLAYERS, D_MODEL), 0.05),
        "w_ffn_gate": nrm(ks[6], (DEPTH, 2, D_MODEL, D_FF), D_MODEL ** -0.5),
        "w_ffn_up": nrm(ks[7], (DEPTH, 2, D_MODEL, D_FF), D_MODEL ** -0.5),
        "w_ffn_down": nrm(ks[8], (DEPTH, 2, D_FF, D_MODEL), D_FF ** -0.5),
        "w_in": nrm(ks[9], (DEPTH, D_MODEL, IN_COLS), D_MODEL ** -0.5),
        "g_kidx": 1.0 + nrm(ks[10], (DEPTH, IDX_DIM), 0.05),
        "rel_bias": nrm(ks[11], (N_BUCKETS, N_HEADS_A), 0.5),
        "g_out_a": 1.0 + nrm(ks[12], (DEPTH, WIDTH_A), 0.05),
        "g_out_b": 1.0 + nrm(ks[13], (DEPTH, WIDTH_B), 0.05),
        "w_out": nrm(ks[14], (DEPTH, MIX_WIDTH, D_MODEL), MIX_WIDTH ** -0.5),
    }


def reference(x, c, w_ada, b_ada, g_pre, g_post, w_ffn_gate, w_ffn_up, w_ffn_down,
              w_in, g_kidx, rel_bias, g_out_a, g_out_b, w_out):
    B, S, _ = x.shape
    h = x
    for l in range(DEPTH):
        mods = (jax.nn.silu(c) @ w_ada[l] + b_ada[l]).reshape(B, N_MOD, D_MODEL)
        shift = lambda i: mods[:, 3 * i]
        scale = lambda i: mods[:, 3 * i + 1]
        gate = lambda i: mods[:, 3 * i + 2][:, None, :]

        n = modulate(rmsnorm(h, g_pre[l, 0]), shift(0), scale(0))
        f = swiglu(n, w_ffn_gate[l, 0], w_ffn_up[l, 0], w_ffn_down[l, 0])
        h = h + 0.5 * gate(0) * rmsnorm(f, g_post[l, 0])

        n = modulate(rmsnorm(h, g_pre[l, 1]), shift(1), scale(1))
        p = n @ w_in[l]
        qa, ka, va, qi, ki, wi, qb, kb, vb = jnp.split(p, IN_SPLITS, axis=-1)
        qa = qa.reshape(B, S, N_HEADS_A, HEAD_DIM)
        ka = ka.reshape(B, S, N_HEADS_A, HEAD_DIM)
        va = va.reshape(B, S, N_HEADS_A, HEAD_DIM)
        qi = qi.reshape(B, S, N_IDX_HEADS, IDX_DIM)
        ki = rmsnorm(ki, g_kidx[l])
        wi = wi * ((N_IDX_HEADS * IDX_DIM) ** -0.5)
        qb = qb.reshape(B, S, N_HEADS_B, HEAD_DIM)
        kb = kb.reshape(B, S, N_HEADS_B, HEAD_DIM)
        vb = vb.reshape(B, S, N_HEADS_B, HEAD_DIM)

        oa = rmsnorm(dsa_sparse_attention(qa, ka, va, qi, ki, wi, rel_bias), g_out_a[l])
        ob = rmsnorm(stick_breaking_attention(qb, kb, vb), g_out_b[l])
        o = jnp.concatenate([oa, ob], axis=-1) @ w_out[l]
        h = h + gate(1) * rmsnorm(o, g_post[l, 1])

        n = modulate(rmsnorm(h, g_pre[l, 2]), shift(2), scale(2))
        f = swiglu(n, w_ffn_gate[l, 1], w_ffn_up[l, 1], w_ffn_down[l, 1])
        h = h + 0.5 * gate(2) * rmsnorm(f, g_post[l, 2])
    return h
```

```cpp
#include <hip/hip_runtime.h>
#include <cstdio>
#include <cstdint>
#include <cmath>

#define LAS __attribute__((address_space(3)))
#define GAS __attribute__((address_space(1)))
typedef unsigned short h16;
typedef _Float16 hf8 __attribute__((ext_vector_type(8)));
typedef _Float16 hf2 __attribute__((ext_vector_type(2)));
typedef float f32x2 __attribute__((ext_vector_type(2)));
typedef float f32x4 __attribute__((ext_vector_type(4)));
typedef float f32x16 __attribute__((ext_vector_type(16)));
typedef unsigned u32x2 __attribute__((ext_vector_type(2)));
typedef unsigned u32x4 __attribute__((ext_vector_type(4)));
typedef short s16x4 __attribute__((ext_vector_type(4)));
typedef short v4i16_t __attribute__((ext_vector_type(4)));

__device__ __forceinline__ unsigned pkh(float lo, float hi) { f32x2 v = {lo, hi}; hf2 h = __builtin_convertvector(v, hf2); return __builtin_bit_cast(unsigned, h); }

constexpr int NB = 16, SEQ = 2048, M = NB * SEQ, D = 1024, FF = 2816, NGU = 2 * FF, NINP = 3840, INCOLS = 3656, NMOD = 9 * D;
constexpr float EPS = 1e-6f;
constexpr float LOG2E = 1.4426950408889634f;
constexpr float C2 = 0.125f * LOG2E;

namespace pg8 {
constexpr int BM = 256, BK = 64, HALF = 128, HTB = HALF * BK * 2, STAGE_BYTES = 8 * HTB, NXCD = 8, WGM = 8;
__host__ __device__ __forceinline__ int lds_byte(int r, int c) { const int st = (r >> 4) * 2 + (c >> 5), rr = r & 15, cc = c & 31, ob = rr * 64 + cc * 2; return st * 1024 + (ob ^ (((ob >> 9) & 1) << 5)); }
__host__ __device__ __forceinline__ void stage_rc(int b, int& R, int& C) { const int st = b / 1024, sb = b % 1024, swz = sb ^ (((sb >> 9) & 1) << 5); R = (st >> 1) * 16 + swz / 64; C = (st & 1) * 32 + (swz % 64) / 2; }
__host__ __device__ __forceinline__ int perm32(int rho) { const int n = rho >> 4, i = rho & 15; return 8 * (i >> 2) + 4 * n + (i & 3); }
struct Unit { int pm, pn; };
struct Gemm { const h16* A; const h16* Bt; int M, N, K; };
struct StaticOrder {
    int nM, nN, nwg, G, c;
    __host__ __device__ void init(int M_, int N_, int G_, int c_) { nM = M_ / BM; nN = N_ / BM; nwg = nM * nN; G = G_; c = c_; }
    __host__ __device__ bool next(int i, Unit& u) const {
        const long L = (long)i * G + c; if (L >= nwg) return false;
        int wgid = (int)L; { const int q = nwg / NXCD, r = nwg % NXCD, xcd = wgid % NXCD, off = wgid / NXCD; wgid = (xcd < r ? xcd * (q + 1) : r * (q + 1) + (xcd - r) * q) + off; }
        const int nig = WGM * nN, gid = wgid / nig, fm = gid * WGM, gsz = (nM - fm) < WGM ? (nM - fm) : WGM;
        u.pm = fm + ((wgid % nig) % gsz); u.pn = (wgid % nig) / gsz; return true;
    }
    __device__ __forceinline__ void a_ready(const Unit&) const {}
    __device__ __forceinline__ void done(const Unit&) const {}
};
__device__ __forceinline__ float silu_mul(float g, float u) { const float e = __builtin_amdgcn_exp2f(-g * LOG2E); return g * u * __builtin_amdgcn_rcpf(1.0f + e); }
struct EpiSwiGLU {
    static constexpr bool PERM = true;
    h16* H;
    __device__ __forceinline__ void operator()(const f32x4 (&acc)[2][2][4][2], const Unit& u, int wr, int wc, int fr, int fq) const {
        const int row0 = u.pm * BM + wr * 64 + fr, col0 = u.pn * HALF + wc * 32 + 8 * fq;
#pragma unroll
        for (int ai = 0; ai < 2; ++ai)
#pragma unroll
            for (int m = 0; m < 4; ++m) {
                const f32x4 g0 = acc[ai][0][m][0], g1 = acc[ai][0][m][1], u0 = acc[ai][1][m][0], u1 = acc[ai][1][m][1];
                u32x4 w; w.x = pkh(silu_mul(g0[0], u0[0]), silu_mul(g0[1], u0[1])); w.y = pkh(silu_mul(g0[2], u0[2]), silu_mul(g0[3], u0[3]));
                w.z = pkh(silu_mul(g1[0], u1[0]), silu_mul(g1[1], u1[1])); w.w = pkh(silu_mul(g1[2], u1[2]), silu_mul(g1[3], u1[3]));
                *(u32x4*)(H + (size_t)(row0 + ai * HALF + m * 16) * FF + col0) = w; }
    }
};
struct EpiF32 {
    static constexpr bool PERM = false;
    float* O; int ldc;
    __device__ __forceinline__ void operator()(const f32x4 (&acc)[2][2][4][2], const Unit& u, int wr, int wc, int fr, int fq) const {
        const int row0 = u.pm * BM + wr * 64 + fr, col0 = u.pn * BM + wc * 32 + 4 * fq;
#pragma unroll
        for (int ai = 0; ai < 2; ++ai)
#pragma unroll
            for (int m = 0; m < 4; ++m) { float* rowp = O + (size_t)(row0 + ai * HALF + m * 16) * ldc + col0;
#pragma unroll
                for (int bj = 0; bj < 2; ++bj)
#pragma unroll
                    for (int n = 0; n < 2; ++n) *(f32x4*)(rowp + bj * HALF + n * 16) = acc[ai][bj][m][n]; }
    }
};
struct EpiInProj {
    static constexpr bool PERM = true;
    h16 *QO, *KA, *VA, *QI, *KB, *VB, *KI; float* WI; const float* gk;
    __device__ __forceinline__ void operator()(const f32x4 (&acc)[2][2][4][2], const Unit& u, int wr, int wc, int fr, int fq) const {
        const int row0 = u.pm * BM + wr * 64 + fr;
        if (u.pn < 14) {
            const int sel = u.pn >> 1; h16* base; int ld = 512, coff = (u.pn & 1) * 256; float sc = 1.0f;
            if (sel == 0) { base = QO; ld = 1024; sc = C2; } else if (sel == 1) { base = QO; ld = 1024; coff += 512; sc = C2; }
            else if (sel == 2) base = KA; else if (sel == 3) base = VA; else if (sel == 4) base = QI; else if (sel == 5) base = KB; else base = VB;
            const int col0 = coff + wc * 32 + 8 * fq;
#pragma unroll
            for (int ai = 0; ai < 2; ++ai)
#pragma unroll
                for (int m = 0; m < 4; ++m) { h16* rowp = base + (size_t)(row0 + ai * HALF + m * 16) * ld + col0;
#pragma unroll
                    for (int bj = 0; bj < 2; ++bj) { const f32x4 v0 = acc[ai][bj][m][0] * sc, v1 = acc[ai][bj][m][1] * sc;
                        u32x4 w; w.x = pkh(v0[0], v0[1]); w.y = pkh(v0[2], v0[3]); w.z = pkh(v1[0], v1[1]); w.w = pkh(v1[2], v1[3]);
                        *(u32x4*)(rowp + bj * HALF) = w; } }
        } else if (wc == 0) {
            f32x4 g[2][2];
#pragma unroll
            for (int bj = 0; bj < 2; ++bj)
#pragma unroll
                for (int n = 0; n < 2; ++n) g[bj][n] = *(const f32x4*)(gk + bj * 32 + 8 * fq + 4 * n);
#pragma unroll
            for (int ai = 0; ai < 2; ++ai)
#pragma unroll
                for (int m = 0; m < 4; ++m) { float ss = 0.f;
#pragma unroll
                    for (int bj = 0; bj < 2; ++bj)
#pragma unroll
                        for (int n = 0; n < 2; ++n) { const f32x4 x = acc[ai][bj][m][n]; ss += (x[0] * x[0] + x[1] * x[1]) + (x[2] * x[2] + x[3] * x[3]); }
                    ss += __shfl_xor(ss, 16); ss += __shfl_xor(ss, 32);
                    const float rstd = 1.0f / sqrtf(ss * (1.0f / 64.0f) + EPS);
                    h16* rowp = KI + (size_t)(row0 + ai * HALF + m * 16) * 64 + 8 * fq;
#pragma unroll
                    for (int bj = 0; bj < 2; ++bj) { const f32x4 v0 = acc[ai][bj][m][0] * rstd * g[bj][0], v1 = acc[ai][bj][m][1] * rstd * g[bj][1];
                        u32x4 w; w.x = pkh(v0[0], v0[1]); w.y = pkh(v0[2], v0[3]); w.z = pkh(v1[0], v1[1]); w.w = pkh(v1[2], v1[3]);
                        *(u32x4*)(rowp + bj * 32) = w; } }
        } else if (wc == 1 && fq == 0) {
            const float ws = 0.044194173824159216f;
#pragma unroll
            for (int ai = 0; ai < 2; ++ai)
#pragma unroll
                for (int m = 0; m < 4; ++m) { float* rowp = WI + (size_t)(row0 + ai * HALF + m * 16) * 8;
                    *(f32x4*)rowp = acc[ai][0][m][0] * ws; *(f32x4*)(rowp + 4) = acc[ai][0][m][1] * ws; }
        }
    }
};

template <class Epi, class Sched>
__device__ __forceinline__ void gemm_phase(LAS unsigned char* lds, const Gemm g, const Sched& S, const Epi& E) {
    const int tid = threadIdx.x, wid = __builtin_amdgcn_readfirstlane(tid >> 6), lane = tid & 63, wr = wid >> 2, wc = wid & 3, fr = lane & 15, fq = lane >> 4;
    const int K = g.K, nt = K / BK;
    unsigned voffA[2], voffB[2];
#pragma unroll
    for (int i = 0; i < 2; ++i) { int R, C; stage_rc(tid * 16 + i * 8192, R, C); const int Rb = Epi::PERM ? ((R & ~31) + perm32(R & 31)) : R;
        voffA[i] = (unsigned)(R * K + C) * 2u; voffB[i] = (unsigned)(Rb * K + C) * 2u; }
    const size_t kstep = (size_t)(BK * 2);
    const size_t hstep = (size_t)HALF * K * 2;
    const size_t tstep = 2 * hstep;
    const unsigned ldsw = (unsigned)wid * 1024u;
    const int aoff = lds_byte(wr * 64 + fr, fq * 8), boff = lds_byte(wc * 32 + fr, fq * 8);
#define PG8_SA(b, h) (((b) * 2 + (h)) * HTB)
#define PG8_SB(b, h) ((4 + (b) * 2 + (h)) * HTB)
#define PG8_STAGE(bufoff, gbase, voff) do { _Pragma("unroll") for (int _i = 0; _i < 2; ++_i) \
        __builtin_amdgcn_global_load_lds((const unsigned*)((const char*)(gbase) + (voff)[_i]), (LAS unsigned*)(lds + (bufoff) + ldsw + _i * 8192), 16, 0, 0); } while (0)
#define PG8_LDA(dst, b, h) do { _Pragma("unroll") for (int m = 0; m < 4; ++m) _Pragma("unroll") for (int k = 0; k < 2; ++k) dst[m][k] = *(const LAS hf8*)(lds + PG8_SA(b, h) + aoff + m * 2048 + k * 1024); } while (0)
#define PG8_LDB(dst, b, h) do { _Pragma("unroll") for (int n = 0; n < 2; ++n) _Pragma("unroll") for (int k = 0; k < 2; ++k) dst[n][k] = *(const LAS hf8*)(lds + PG8_SB(b, h) + boff + n * 2048 + k * 1024); } while (0)
#define PG8_MMA(ai, bj, At, Bt) do { __builtin_amdgcn_s_setprio(1); _Pragma("unroll") for (int m = 0; m < 4; ++m) _Pragma("unroll") for (int n = 0; n < 2; ++n) _Pragma("unroll") for (int k = 0; k < 2; ++k) \
        acc[ai][bj][m][n] = __builtin_amdgcn_mfma_f32_16x16x32_f16(Bt[n][k], At[m][k], acc[ai][bj][m][n], 0, 0, 0); __builtin_amdgcn_s_setprio(0); } while (0)
#define PG8_WAIT_V(n) asm volatile("s_waitcnt vmcnt(" #n ")" ::: "memory")
#define PG8_WAIT_L(n) asm volatile("s_waitcnt lgkmcnt(" #n ")" ::: "memory")
#define PG8_BAR __builtin_amdgcn_s_barrier()
#define PG8_SCHED __builtin_amdgcn_sched_barrier(0)
    Unit cur, nxt; int ui = 0;
    if (!S.next(0, cur)) return;
    f32x4 acc[2][2][4][2];
#pragma unroll
    for (int a = 0; a < 2; ++a)
#pragma unroll
        for (int b = 0; b < 2; ++b)
#pragma unroll
            for (int m = 0; m < 4; ++m)
#pragma unroll
                for (int n = 0; n < 2; ++n) acc[a][b][m][n] = (f32x4){0.f, 0.f, 0.f, 0.f};
    hf8 At[4][2], B0[2][2], B1[2][2];
    const char* cA = (const char*)g.A + (size_t)cur.pm * tstep; const char* cB = (const char*)g.Bt + (size_t)cur.pn * tstep;
    S.a_ready(cur);
    PG8_STAGE(PG8_SB(0, 0), cB, voffB); PG8_STAGE(PG8_SB(0, 1), cB + hstep, voffB); PG8_STAGE(PG8_SA(0, 0), cA, voffA); PG8_STAGE(PG8_SA(0, 1), cA + hstep, voffA);
    if (wr == 1) PG8_BAR;
    PG8_WAIT_V(2); PG8_BAR;
    PG8_STAGE(PG8_SB(1, 0), cB + kstep, voffB); PG8_STAGE(PG8_SA(1, 0), cA + kstep, voffA); PG8_STAGE(PG8_SB(1, 1), cB + hstep + kstep, voffB);
    PG8_WAIT_V(6); PG8_BAR;
    for (;;) {
        const bool has_next = S.next(ui + 1, nxt);
        const char* nA = has_next ? (const char*)g.A + (size_t)nxt.pm * tstep : cA; const char* nB = has_next ? (const char*)g.Bt + (size_t)nxt.pn * tstep : cB;
        for (int t = 0; t < nt; t += 2) {
            const bool last = (t == nt - 2);
            const char* a1 = cA + (size_t)(t + 1) * kstep;
            const char* a2 = last ? nA : cA + (size_t)(t + 2) * kstep; const char* b2 = last ? nB : cB + (size_t)(t + 2) * kstep;
            const char* a3 = a2 + kstep; const char* b3 = b2 + kstep;
            if (last && has_next) S.a_ready(nxt);
            PG8_LDB(B0, 0, 0); PG8_LDB(B1, 0, 1); PG8_SCHED; PG8_LDA(At, 0, 0); PG8_STAGE(PG8_SA(1, 1), a1 + hstep, voffA);
            PG8_WAIT_V(8); PG8_WAIT_L(0); PG8_BAR; PG8_MMA(0, 0, At, B0); PG8_MMA(0, 1, At, B1); PG8_BAR; PG8_SCHED;
            PG8_LDA(At, 0, 1); PG8_STAGE(PG8_SB(0, 0), b2, voffB); PG8_STAGE(PG8_SB(0, 1), b2 + hstep, voffB); PG8_STAGE(PG8_SA(0, 0), a2, voffA);
            PG8_WAIT_V(8); PG8_WAIT_L(0); PG8_BAR; PG8_MMA(1, 0, At, B0); PG8_MMA(1, 1, At, B1); PG8_BAR; PG8_SCHED;
            PG8_LDB(B0, 1, 0); PG8_LDB(B1, 1, 1); PG8_SCHED; PG8_LDA(At, 1, 0); PG8_STAGE(PG8_SA(0, 1), a2 + hstep, voffA);
            PG8_WAIT_V(8); PG8_WAIT_L(0); PG8_BAR; PG8_MMA(0, 0, At, B0); PG8_MMA(0, 1, At, B1); PG8_BAR; PG8_SCHED;
            PG8_LDA(At, 1, 1); PG8_STAGE(PG8_SB(1, 0), b3, voffB); PG8_STAGE(PG8_SB(1, 1), b3 + hstep, voffB); PG8_STAGE(PG8_SA(1, 0), a3, voffA);
            PG8_WAIT_V(8); PG8_WAIT_L(0); PG8_BAR; PG8_MMA(1, 0, At, B0); PG8_MMA(1, 1, At, B1); PG8_BAR; PG8_SCHED;
        }
        if (wr == 0) PG8_BAR;
        E(acc, cur, wr, wc, fr, fq); S.done(cur);
        if (!has_next) break;
#pragma unroll
        for (int a = 0; a < 2; ++a)
#pragma unroll
            for (int b = 0; b < 2; ++b)
#pragma unroll
                for (int m = 0; m < 4; ++m)
#pragma unroll
                    for (int n = 0; n < 2; ++n) acc[a][b][m][n] = (f32x4){0.f, 0.f, 0.f, 0.f};
        cur = nxt; cA = nA; cB = nB; ++ui;
        if (wr == 1) PG8_BAR;
    }
    PG8_WAIT_V(0);
    PG8_BAR;
#undef PG8_SA
#undef PG8_SB
#undef PG8_STAGE
#undef PG8_LDA
#undef PG8_LDB
#undef PG8_MMA
#undef PG8_WAIT_V
#undef PG8_WAIT_L
#undef PG8_BAR
#undef PG8_SCHED
}
}

constexpr int NWAVES = 8;
constexpr int NPHASE = 14;
#ifndef MK_N_LAUNCHES
#define MK_N_LAUNCHES 1
#endif
constexpr int N_LAUNCHES = MK_N_LAUNCHES;
#ifndef MK_DEBUG_STOP
#define MK_DEBUG_STOP 99
#endif
#ifndef MK_DEBUG_MODE
#define MK_DEBUG_MODE 100
#endif

constexpr size_t MiB = 1u << 20;
constexpr size_t WS_CTL = 0, CTL_ZERO_BYTES = 1 * MiB;
constexpr size_t WS_MODS = 1 * MiB;
constexpr size_t WS_WGU1 = 2 * MiB, WS_WGU2 = 13 * MiB, WS_WD1 = 24 * MiB, WS_WD2 = 30 * MiB, WS_WIN = 36 * MiB, WS_WOUT = 44 * MiB;
constexpr size_t WS_XN = 48 * MiB;
constexpr size_t WS_H = 112 * MiB;
constexpr size_t WS_QO = 112 * MiB, WS_KA = 176 * MiB, WS_VA = 208 * MiB, WS_QI = 240 * MiB, WS_KI = 272 * MiB, WS_WI = 276 * MiB, WS_MASK = 277 * MiB;
constexpr size_t WS_H1 = 288 * MiB;
constexpr size_t WS_KB = 416 * MiB, WS_VB = 448 * MiB, WS_END = 480 * MiB;
static_assert(WS_H + (size_t)M * FF * 2 <= WS_H1 && WS_MASK + (size_t)M * 256 <= WS_H1 && WS_WOUT + (size_t)D * D * 2 <= WS_XN, "d_ws map");
constexpr int CW_TMO = 0, CW_BAR = 4096;

constexpr int RING_OFF = 0, RING_BYTES = 135168;
constexpr int LDSCTL_OFF = RING_BYTES, MISC_OFF = LDSCTL_OFF + 320;
constexpr int LDS_BYTES = 147456;

typedef GAS unsigned gu32;
#define RLX_AGENT __ATOMIC_RELAXED, __HIP_MEMORY_SCOPE_AGENT
#define LDS_WAIT() asm volatile("s_waitcnt lgkmcnt(0)" ::: "memory")
#define VM_WAIT() asm volatile("s_waitcnt vmcnt(0)" ::: "memory")

#define XB_TMO      128
#define XB_XCNT(j)  (256  + 64 * (j))
#define XB_XSUB(j)  (1280 + 64 * (j))
#define XB_XGEN(j)  (2304 + 64 * (j))
#define XB_TOP      3328
#define XB_TOPGEN   3392
#define XCD_BAR_WORDS 3456
#define XB_SPIN_CAP (1u << 18)
__device__ __forceinline__ unsigned xb_ld(unsigned* p)              { return __hip_atomic_load(p, __ATOMIC_RELAXED, __HIP_MEMORY_SCOPE_AGENT); }
__device__ __forceinline__ unsigned xb_add(unsigned* p, unsigned v) { return __hip_atomic_fetch_add(p, v, __ATOMIC_RELAXED, __HIP_MEMORY_SCOPE_AGENT); }
__device__ __forceinline__ unsigned xb_xcc_id() { return (unsigned)__builtin_amdgcn_s_getreg((3 << 11) | 20) & 0xFu; }
#define XB_SPIN(cond, bar) do { unsigned _sp = 0; while (cond) { __builtin_amdgcn_s_sleep(1); \
    if ((++_sp & 255u) == 0u) { if (xb_ld(&(bar)[XB_TMO])) break; if (_sp > XB_SPIN_CAP) { atomicAdd(&(bar)[XB_TMO], 1u); break; } } } } while (0)
struct XcdBarrier { unsigned* bar; unsigned x; volatile LAS unsigned* st; };
__device__ __forceinline__ XcdBarrier xcd_barrier_post(unsigned* bar, volatile LAS unsigned* st) {
    XcdBarrier b; b.bar = bar; b.x = xb_xcc_id(); b.st = st;
    if (threadIdx.x == 0) (void)xb_add(&bar[XB_XCNT(b.x)], 1u);
    return b;
}
__device__ __forceinline__ void xcd_barrier_complete(unsigned* bar, unsigned x, unsigned& nloc, unsigned& nx) {
    const unsigned G = gridDim.x * gridDim.y * gridDim.z;
    unsigned sum, cnt, mine, sp = 0u;
    for (;;) {
        sum = 0u; cnt = 0u; mine = 0u;
#pragma unroll
        for (unsigned j = 0; j < 16; ++j) { const unsigned c = xb_ld(&bar[XB_XCNT(j)]); sum += c; cnt += (c > 0u) ? 1u : 0u; mine = (j == x) ? c : mine; }
        if (sum == G) break;
        __builtin_amdgcn_s_sleep(1);
        if ((++sp & 255u) == 0u) { if (xb_ld(&bar[XB_TMO])) break; if (sp > XB_SPIN_CAP) { atomicAdd(&bar[XB_TMO], 1u); break; } }
    }
    nloc = mine > 0u ? mine : 1u; nx = cnt > 0u ? cnt : 1u;
}
__device__ __forceinline__ void xcd_barrier(const XcdBarrier& b) {
    asm volatile("s_waitcnt vmcnt(0)" ::: "memory");
    __syncthreads();
    if (threadIdx.x == 0) {
        unsigned* bar = b.bar;
        __builtin_amdgcn_s_waitcnt(0);
        unsigned nloc = b.st[0], nx = b.st[1];
        if (nloc == 0u) { xcd_barrier_complete(bar, b.x, nloc, nx); b.st[0] = nloc; b.st[1] = nx; }
        const unsigned old = xb_add(&bar[XB_XSUB(b.x)], 1u);
        const unsigned gen = old / nloc;
        if (old + 1u == (gen + 1u) * nloc) {
            __builtin_amdgcn_fence(__ATOMIC_RELEASE, "agent");
            asm volatile("s_waitcnt vmcnt(0)" ::: "memory");
            const unsigned og = xb_add(&bar[XB_TOP], 1u);
            const unsigned tg = og / nx;
            if (og + 1u == (tg + 1u) * nx) xb_add(&bar[XB_TOPGEN], 1u);
            else XB_SPIN(xb_ld(&bar[XB_TOPGEN]) == tg, bar);
            __builtin_amdgcn_fence(__ATOMIC_ACQUIRE, "agent");
            xb_add(&bar[XB_XGEN(b.x)], 1u);
            asm volatile("s_waitcnt vmcnt(0)" ::: "memory");
        } else {
            XB_SPIN(xb_ld(&bar[XB_XGEN(b.x)]) == gen, bar);
            __builtin_amdgcn_fence(__ATOMIC_ACQUIRE, "agent");
            asm volatile("s_waitcnt vmcnt(0)" ::: "memory");
        }
    }
    __syncthreads();
}

struct Frame {
    LAS unsigned char* lds;
    int tid, lane, wave, vcu, G;
    const float *x, *c, *w_ada, *b_ada, *g_pre, *g_post, *w_gate, *w_up, *w_down, *w_in, *g_kidx, *rel_bias, *g_out_a, *g_out_b, *w_out;
    float* out;
    unsigned char* ws;
    __device__ __forceinline__ float* mods() const { return (float*)(ws + WS_MODS); }
    __device__ __forceinline__ h16* Wgu(int l) const { return (h16*)(ws + (l ? WS_WGU2 : WS_WGU1)); }
    __device__ __forceinline__ h16* Wd(int l) const { return (h16*)(ws + (l ? WS_WD2 : WS_WD1)); }
    __device__ __forceinline__ h16* Win() const { return (h16*)(ws + WS_WIN); }
    __device__ __forceinline__ h16* Wout() const { return (h16*)(ws + WS_WOUT); }
    __device__ __forceinline__ h16* XN() const { return (h16*)(ws + WS_XN); }
    __device__ __forceinline__ h16* H() const { return (h16*)(ws + WS_H); }
    __device__ __forceinline__ h16* QO() const { return (h16*)(ws + WS_QO); }
    __device__ __forceinline__ h16* KA() const { return (h16*)(ws + WS_KA); }
    __device__ __forceinline__ h16* VA() const { return (h16*)(ws + WS_VA); }
    __device__ __forceinline__ h16* QI() const { return (h16*)(ws + WS_QI); }
    __device__ __forceinline__ h16* KI() const { return (h16*)(ws + WS_KI); }
    __device__ __forceinline__ h16* KB() const { return (h16*)(ws + WS_KB); }
    __device__ __forceinline__ h16* VB() const { return (h16*)(ws + WS_VB); }
    __device__ __forceinline__ float* WI() const { return (float*)(ws + WS_WI); }
    __device__ __forceinline__ float* H1() const { return (float*)(ws + WS_H1); }
    __device__ __forceinline__ unsigned long long* MASK() const { return (unsigned long long*)(ws + WS_MASK); }
};
__device__ __forceinline__ float wave_sum(float v) {
#pragma unroll
    for (int o = 1; o < 64; o <<= 1) v += __shfl_xor(v, o);
    return v;
}
#define WG_BAR() asm volatile("s_waitcnt vmcnt(0) lgkmcnt(0)\n\ts_barrier" ::: "memory")

__device__ __forceinline__ void adaln_unit(const Frame& F, int u) {
    LAS float* s = (LAS float*)(F.lds + RING_OFF);
    LAS float* red = s + 16 * 1024;
    for (int i = F.tid; i < 16 * 1024; i += NWAVES * 64) { const float cv = F.c[i]; s[i] = cv / (1.0f + __expf(-cv)); }
    WG_BAR();
    float acc[16];
#pragma unroll
    for (int b = 0; b < 16; ++b) acc[b] = 0.f;
    const float* wp = F.w_ada + (size_t)(128 * F.wave) * NMOD + 64 * u + F.lane;
    for (int k = 0; k < 128; k += 4) {
        const float w0 = wp[(size_t)(k + 0) * NMOD], w1 = wp[(size_t)(k + 1) * NMOD], w2 = wp[(size_t)(k + 2) * NMOD], w3 = wp[(size_t)(k + 3) * NMOD];
#pragma unroll
        for (int b = 0; b < 16; ++b) { const f32x4 sv = *(const LAS f32x4*)(s + b * 1024 + 128 * F.wave + k); acc[b] += (sv.x * w0 + sv.y * w1) + (sv.z * w2 + sv.w * w3); }
    }
#pragma unroll
    for (int b = 0; b < 16; ++b) red[(F.wave * 16 + b) * 64 + F.lane] = acc[b];
    WG_BAR();
    for (int i = F.tid; i < 16 * 64; i += NWAVES * 64) { const int b = i >> 6, l = i & 63; float t = F.b_ada[64 * u + l];
#pragma unroll
        for (int w = 0; w < 8; ++w) t += red[(w * 16 + b) * 64 + l];
        F.mods()[(size_t)b * NMOD + 64 * u + l] = t; }
    WG_BAR();
}
__device__ __forceinline__ void tr_item(const float* W, int ldw, int k0, int src_col0, int ncols, h16* WT, int dst_row0, int K, LAS float* scr, int lane) {
    const int cl = lane & 31;
#pragma unroll 8
    for (int i = 0; i < 32; ++i) { const int kk = 2 * i + (lane >> 5); scr[kk * 33 + cl] = (cl < ncols) ? W[(size_t)(k0 + kk) * ldw + src_col0 + cl] : 0.f; }
    LDS_WAIT(); asm volatile("" ::: "memory");
    const int c = lane & 7;
#pragma unroll
    for (int j = 0; j < 4; ++j) { const int n = (lane >> 3) + 8 * j; const LAS float* sp = scr + (8 * c) * 33 + n;
        u32x4 o; o.x = pkh(sp[0 * 33], sp[1 * 33]); o.y = pkh(sp[2 * 33], sp[3 * 33]); o.z = pkh(sp[4 * 33], sp[5 * 33]); o.w = pkh(sp[6 * 33], sp[7 * 33]);
        *(GAS u32x4*)(WT + (size_t)(dst_row0 + n) * K + k0 + 8 * c) = o; }
    LDS_WAIT(); asm volatile("" ::: "memory");
}
__device__ __forceinline__ void p0_prologue(const Frame& F) {
    if (F.vcu < 144) adaln_unit(F, F.vcu);
    LAS float* scr = (LAS float*)(F.lds + RING_OFF + F.wave * 16384);
    const int gw = F.vcu * NWAVES + F.wave, NGW = F.G * NWAVES;
    constexpr int I_GU = 16 * 176, I_DN = 44 * 32, I_IN = 16 * 120, I_OUT = 16 * 32, NITEMS = 2 * I_GU + 2 * I_DN + I_IN + I_OUT;
    for (int it = gw; it < NITEMS; it += NGW) {
        int r = it;
        if (r < 2 * I_GU) { const int l = r / I_GU; r -= l * I_GU; const int kb = r / 176, nb = r % 176, pn = nb >> 3, rr = (nb & 7) * 32;
            const float* src = (rr < 128 ? F.w_gate : F.w_up) + (size_t)l * D * FF;
            tr_item(src, FF, 64 * kb, 128 * pn + (rr & 127), 32, F.Wgu(l), 32 * nb, D, scr, F.lane); continue; }
        r -= 2 * I_GU;
        if (r < 2 * I_DN) { const int l = r / I_DN; r -= l * I_DN; const int kb = r / 32, nb = r % 32;
            tr_item(F.w_down + (size_t)l * FF * D, D, 64 * kb, 32 * nb, 32, F.Wd(l), 32 * nb, FF, scr, F.lane); continue; }
        r -= 2 * I_DN;
        if (r < I_IN) { const int kb = r / 120, nb = r % 120, pn = nb >> 3, sel = pn >> 1; int sc0, nc = 32;
            if (pn < 14) { const int base = (sel == 0) ? 0 : (sel == 1) ? 2120 : (sel == 2) ? 512 : (sel == 3) ? 1024 : (sel == 4) ? 1536 : (sel == 5) ? 2632 : 3144; sc0 = base + 32 * nb - 512 * sel; }
            else { const int gI = nb & 7; if (gI == 0) sc0 = 2048; else if (gI == 1) { sc0 = 2112; nc = 8; } else if (gI == 4) sc0 = 2080; else { sc0 = 0; nc = 0; } }
            tr_item(F.w_in, INCOLS, 64 * kb, sc0, nc, F.Win(), 32 * nb, D, scr, F.lane); continue; }
        r -= I_IN;
        { const int kb = r / 32, nb = r % 32; tr_item(F.w_out, D, 64 * kb, 32 * nb, 32, F.Wout(), 32 * nb, D, scr, F.lane); }
    }
}

__device__ __forceinline__ void prenorm_phase(const Frame& F, const float* src, int ns) {
    const int gw = F.vcu * NWAVES + F.wave, NGW = F.G * NWAVES;
    for (int r0 = gw * 16; r0 < M; r0 += NGW * 16) {
        const int b = r0 / SEQ; const float* md = F.mods() + (size_t)b * NMOD;
        f32x4 a2[4], b2[4];
#pragma unroll
        for (int j = 0; j < 4; ++j) { const int col = 4 * F.lane + 256 * j; const f32x4 g = *(const f32x4*)(F.g_pre + ns * D + col), sc = *(const f32x4*)(md + (3 * ns + 1) * D + col);
            a2[j] = g * (1.0f + sc); b2[j] = *(const f32x4*)(md + (3 * ns) * D + col); }
        for (int r = r0; r < r0 + 16; ++r) {
            const GAS f32x4* xr = (const GAS f32x4*)(src + (size_t)r * D) + F.lane; f32x4 v[4]; float s = 0.f;
#pragma unroll
            for (int j = 0; j < 4; ++j) { v[j] = xr[64 * j]; s += (v[j].x * v[j].x + v[j].y * v[j].y) + (v[j].z * v[j].z + v[j].w * v[j].w); }
            const float rstd = 1.0f / sqrtf(wave_sum(s) * (1.0f / D) + EPS);
            GAS u32x2* o8 = (GAS u32x2*)(F.XN() + (size_t)r * D) + F.lane;
#pragma unroll
            for (int j = 0; j < 4; ++j) { const f32x4 n = v[j] * rstd * a2[j] + b2[j]; u32x2 w; w.x = pkh(n.x, n.y); w.y = pkh(n.z, n.w); o8[64 * j] = w; }
        }
    }
}
__device__ __forceinline__ void resnorm_phase(const Frame& F, const float* fsrc, const float* base, float* hout, int sub, float gmul, int ns) {
    const int gw = F.vcu * NWAVES + F.wave, NGW = F.G * NWAVES;
    for (int r0 = gw * 16; r0 < M; r0 += NGW * 16) {
        const int b = r0 / SEQ; const float* md = F.mods() + (size_t)b * NMOD;
        f32x4 c1[4], a2[4], b2[4];
#pragma unroll
        for (int j = 0; j < 4; ++j) { const int col = 4 * F.lane + 256 * j;
            c1[j] = *(const f32x4*)(md + (3 * sub + 2) * D + col) * *(const f32x4*)(F.g_post + sub * D + col) * gmul;
            if (ns >= 0) { const f32x4 g = *(const f32x4*)(F.g_pre + ns * D + col), sc = *(const f32x4*)(md + (3 * ns + 1) * D + col); a2[j] = g * (1.0f + sc); b2[j] = *(const f32x4*)(md + (3 * ns) * D + col); }
            else { a2[j] = (f32x4){0.f, 0.f, 0.f, 0.f}; b2[j] = a2[j]; } }
        for (int r = r0; r < r0 + 16; ++r) {
            const GAS f32x4* fr = (const GAS f32x4*)(fsrc + (size_t)r * D) + F.lane; const GAS f32x4* br = (const GAS f32x4*)(base + (size_t)r * D) + F.lane;
            f32x4 f[4], h[4]; float s = 0.f;
#pragma unroll
            for (int j = 0; j < 4; ++j) { f[j] = fr[64 * j]; h[j] = br[64 * j]; s += (f[j].x * f[j].x + f[j].y * f[j].y) + (f[j].z * f[j].z + f[j].w * f[j].w); }
            const float rstd = 1.0f / sqrtf(wave_sum(s) * (1.0f / D) + EPS);
            GAS f32x4* ho = (GAS f32x4*)(hout + (size_t)r * D) + F.lane; float s2 = 0.f;
#pragma unroll
            for (int j = 0; j < 4; ++j) { h[j] = h[j] + c1[j] * f[j] * rstd; ho[64 * j] = h[j]; s2 += (h[j].x * h[j].x + h[j].y * h[j].y) + (h[j].z * h[j].z + h[j].w * h[j].w); }
            if (ns >= 0) {
                const float r2 = 1.0f / sqrtf(wave_sum(s2) * (1.0f / D) + EPS);
                GAS u32x2* o8 = (GAS u32x2*)(F.XN() + (size_t)r * D) + F.lane;
#pragma unroll
                for (int j = 0; j < 4; ++j) { const f32x4 n = h[j] * r2 * a2[j] + b2[j]; u32x2 w; w.x = pkh(n.x, n.y); w.y = pkh(n.z, n.w); o8[64 * j] = w; }
            }
        }
    }
}
__device__ __forceinline__ void onorm_phase(const Frame& F) {
    const int gw = F.vcu * NWAVES + F.wave, NGW = F.G * NWAVES;
    f32x4 ga[2][2];
#pragma unroll
    for (int j = 0; j < 2; ++j)
#pragma unroll
        for (int e = 0; e < 2; ++e) ga[j][e] = *(const f32x4*)((j == 0 ? F.g_out_a : F.g_out_b) + 8 * F.lane + 4 * e);
    for (int r = gw; r < M; r += NGW) {
        GAS u32x4* p = (GAS u32x4*)(F.QO() + (size_t)r * D) + F.lane;
#pragma unroll
        for (int j = 0; j < 2; ++j) {
            const u32x4 raw = p[64 * j]; const hf8 hv = __builtin_bit_cast(hf8, raw); float v[8]; float s = 0.f;
#pragma unroll
            for (int e = 0; e < 8; ++e) { v[e] = (float)hv[e]; s += v[e] * v[e]; }
            const float rstd = 1.0f / sqrtf(wave_sum(s) * (1.0f / 512.0f) + EPS);
            u32x4 w; w.x = pkh(v[0] * rstd * ga[j][0][0], v[1] * rstd * ga[j][0][1]); w.y = pkh(v[2] * rstd * ga[j][0][2], v[3] * rstd * ga[j][0][3]);
            w.z = pkh(v[4] * rstd * ga[j][1][0], v[5] * rstd * ga[j][1][1]); w.w = pkh(v[6] * rstd * ga[j][1][2], v[7] * rstd * ga[j][1][3]);
            p[64 * j] = w;
        }
    }
}

constexpr int SC_LD = 2052;
__device__ __forceinline__ unsigned f2ord(float f) { const unsigned u = __builtin_bit_cast(unsigned, f); return (u & 0x80000000u) ? ~u : (u | 0x80000000u); }
__device__ __forceinline__ float ord2f(unsigned o) { const unsigned u = (o & 0x80000000u) ? (o & 0x7fffffffu) : ~o; return __builtin_bit_cast(float, u); }
__device__ __forceinline__ void idx_unit(const Frame& F, int b, int blk) {
    LAS float* sc = (LAS float*)(F.lds + RING_OFF);
    const int lane = F.lane, wid = F.wave, t0 = blk * 16; const size_t rowbase = (size_t)b * SEQ;
    {
        const h16* qp = F.QI() + (rowbase + t0 + (lane & 15)) * 512 + (lane >> 4) * 8;
        hf8 bq[8][2];
#pragma unroll
        for (int h = 0; h < 8; ++h)
#pragma unroll
            for (int ks = 0; ks < 2; ++ks) bq[h][ks] = __builtin_bit_cast(hf8, *(const u32x4*)(qp + h * 64 + ks * 32));
        const float* wp = F.WI() + (rowbase + t0 + (lane & 15)) * 8; const f32x4 wa = *(const f32x4*)wp, wb = *(const f32x4*)(wp + 4);
        const float w[8] = {wa.x, wa.y, wa.z, wa.w, wb.x, wb.y, wb.z, wb.w};
        for (int kt = wid; kt <= blk; kt += NWAVES) {
            const h16* kp = F.KI() + (rowbase + 16 * kt + (lane & 15)) * 64 + (lane >> 4) * 8;
            const hf8 a0 = __builtin_bit_cast(hf8, *(const u32x4*)kp), a1 = __builtin_bit_cast(hf8, *(const u32x4*)(kp + 32));
            f32x4 acc = {0.f, 0.f, 0.f, 0.f};
#pragma unroll
            for (int h = 0; h < 8; ++h) { f32x4 d = __builtin_amdgcn_mfma_f32_16x16x32_f16(a0, bq[h][0], (f32x4){0.f, 0.f, 0.f, 0.f}, 0, 0, 0); d = __builtin_amdgcn_mfma_f32_16x16x32_f16(a1, bq[h][1], d, 0, 0, 0);
#pragma unroll
                for (int i = 0; i < 4; ++i) acc[i] += w[h] * fmaxf(d[i], 0.f); }
            *(LAS f32x4*)(sc + (lane & 15) * SC_LD + 16 * kt + 4 * (lane >> 4)) = acc;
        }
    }
    WG_BAR();
    for (int rr = 0; rr < 2; ++rr) {
        const int row = 2 * wid + rr, t = t0 + row; float v[32];
        const float NINF = -__builtin_inff();
#pragma unroll
        for (int j = 0; j < 32; ++j) { const int key = 64 * j + lane; const float x = sc[row * SC_LD + key]; v[j] = (key <= t) ? x : NINF; }
        float theta = NINF; bool ties = false; int take = 0;
        if (t + 1 > 256) {
            float mx = v[0], mn = (lane <= t) ? v[0] : __builtin_inff();
#pragma unroll
            for (int j = 1; j < 32; ++j) { mx = fmaxf(mx, v[j]); mn = fminf(mn, (64 * j + lane <= t) ? v[j] : __builtin_inff()); }
#pragma unroll
            for (int o = 1; o < 64; o <<= 1) { mx = fmaxf(mx, __shfl_xor(mx, o)); mn = fminf(mn, __shfl_xor(mn, o)); }
            float lo = __builtin_bit_cast(float, __builtin_amdgcn_readfirstlane(__builtin_bit_cast(int, mn)));
            float hi = __builtin_bit_cast(float, __builtin_amdgcn_readfirstlane(__builtin_bit_cast(int, mx)));
#define CGE(x, out) do { int c_ = 0; _Pragma("unroll") for (int j = 0; j < 32; ++j) c_ += __popcll(__ballot(v[j] >= (x))); out = c_; } while (0)
            int chi; CGE(hi, chi);
            if (chi >= 256) { theta = hi; if (chi > 256) { ties = true; take = 256; } }
            else {
                for (int it = 0; ; ++it) {
                    float mid = lo + (hi - lo) * 0.5f;
                    if (it >= 24 || !(mid > lo && mid < hi)) { const unsigned ul = f2ord(lo), uh = f2ord(hi), um = ul + ((uh - ul) >> 1);
                        if (um == ul) { theta = lo; ties = true; take = 256 - chi; break; }
                        mid = ord2f(um); }
                    int c; CGE(mid, c);
                    if (c == 256) { theta = mid; break; }
                    if (c > 256) lo = mid; else { hi = mid; chi = c; }
                }
            }
#undef CGE
        }
        unsigned long long mine = 0ull;
        if (!ties) {
#pragma unroll
            for (int j = 0; j < 32; ++j) { const unsigned long long bj = __ballot(v[j] >= theta && (64 * j + lane <= t)); if (lane == j) mine = bj; }
        } else {
            int left = take;
#pragma unroll
            for (int j = 0; j < 32; ++j) { const unsigned long long gt = __ballot(v[j] > theta); unsigned long long eq = __ballot(v[j] == theta);
                int ne = __popcll(eq); while (ne > left) { eq &= ~(1ull << (63 - __builtin_clzll(eq))); --ne; }
                left -= ne; if (lane == j) mine = gt | eq; }
        }
        if (lane < 32) F.MASK()[(rowbase + t) * 32 + lane] = mine;
    }
    WG_BAR();
}

__device__ __forceinline__ void idx_naive_phase(const Frame& F) {
    LAS float* qs = (LAS float*)(F.lds + RING_OFF) + F.wave * 2560;
    LAS float* ss = qs + 512;
    const int gw = F.vcu * NWAVES + F.wave, NGW = F.G * NWAVES, lane = F.lane;
    for (int row = gw; row < M; row += NGW) {
        const int b = row / SEQ, t = row % SEQ; const size_t rowbase = (size_t)b * SEQ;
        for (int i = lane; i < 512; i += 64) { const _Float16 hv = __builtin_bit_cast(_Float16, F.QI()[(size_t)row * 512 + i]); qs[i] = (float)hv; }
        float w[8];
#pragma unroll
        for (int h = 0; h < 8; ++h) w[h] = F.WI()[(size_t)row * 8 + h];
        LDS_WAIT();
        for (int j = 0; j < 32; ++j) { const int key = 64 * j + lane; float sc = -__builtin_inff();
            if (key <= t) { const h16* kp = F.KI() + (rowbase + key) * 64; float d[8];
#pragma unroll
                for (int h = 0; h < 8; ++h) d[h] = 0.f;
#pragma unroll
                for (int c = 0; c < 8; ++c) { const hf8 v = __builtin_bit_cast(hf8, *(const u32x4*)(kp + 8 * c));
#pragma unroll
                    for (int h = 0; h < 8; ++h)
#pragma unroll
                        for (int e = 0; e < 8; ++e) d[h] += qs[h * 64 + 8 * c + e] * (float)v[e]; }
                sc = 0.f;
#pragma unroll
                for (int h = 0; h < 8; ++h) sc += w[h] * fmaxf(d[h], 0.f); }
            ss[key] = sc; }
        LDS_WAIT();
        unsigned long long mine = 0ull;
        for (int j = 0; j < 32; ++j) { const int key = 64 * j + lane; const float me = ss[key]; int rank = 0;
            for (int k2 = 0; k2 <= t; ++k2) { const float o = ss[k2]; rank += (o > me || (o == me && k2 < key)) ? 1 : 0; }
            const unsigned long long bj = __ballot(key <= t && rank < 256); if (lane == j) mine = bj; }
        if (lane < 32) F.MASK()[(size_t)row * 32 + lane] = mine;
        LDS_WAIT();
    }
}
__device__ __forceinline__ void idx_phase(const Frame& F) {
    for (int i = 0; ; ++i) { const int u = i * F.G + F.vcu; if (u >= NB * 128) break;
        const int rnd = u >> 8, c = u & 255, b = c >> 4, s = c & 15, blk = (rnd & 1) ? 16 * rnd + 15 - s : 16 * rnd + s;
        idx_unit(F, b, blk); }
}

namespace att {
constexpr int SLOTB = 8192, L_K = 0, L_V = 2 * SLOTB, L_WS = 4 * SLOTB, L_OST = L_WS + NWAVES * 64 * 4, L_TBL = L_OST + NWAVES * 4096, L_FLAG = L_TBL + 384 * 4, L_END = L_FLAG + 16;
static_assert(L_END <= RING_BYTES, "attention LDS map");
__device__ __forceinline__ int crow(int r, int hi) { return (r & 3) + 8 * (r >> 2) + 4 * hi; }
__device__ __forceinline__ void glds16(const void* gsrc, unsigned lds_dst) { unsigned keep;
    asm volatile("s_mov_b32 %0, m0\n\ts_mov_b32 m0, %2\n\ts_nop 0\n\tglobal_load_lds_dwordx4 %1, off\n\ts_mov_b32 m0, %0" : "=&s"(keep) : "v"(gsrc), "s"(lds_dst) : "memory"); }
#define ATT_WAIT_BAR(N) asm volatile("s_waitcnt vmcnt(" #N ") lgkmcnt(0)\n\ts_barrier" ::: "memory")
__device__ __forceinline__ void qkt(f32x16& p0, f32x16& p1, const LAS unsigned char* Kslot, const hf8* qr, const f32x16& ci, int r32, int hi) {
    const LAS unsigned char* kb = Kslot + hi * 1024 + r32 * 16;
#pragma unroll
    for (int d0 = 0; d0 < 4; ++d0) {
        const hf8 b0 = *(const LAS hf8*)(kb + d0 * 2048), b1 = *(const LAS hf8*)(kb + d0 * 2048 + 512);
        if (d0 == 0) { p0 = __builtin_amdgcn_mfma_f32_32x32x16_f16(b0, qr[0], ci, 0, 0, 0); p1 = __builtin_amdgcn_mfma_f32_32x32x16_f16(b1, qr[0], ci, 0, 0, 0); }
        else { p0 = __builtin_amdgcn_mfma_f32_32x32x16_f16(b0, qr[d0], p0, 0, 0, 0); p1 = __builtin_amdgcn_mfma_f32_32x32x16_f16(b1, qr[d0], p1, 0, 0, 0); } }
}
__device__ __forceinline__ s16x4 vtr(const LAS unsigned char* p) { return __builtin_bit_cast(s16x4, __builtin_amdgcn_ds_read_tr16_b64_v4i16((LAS v4i16_t*)p)); }
__device__ __forceinline__ void pv(f32x16* o, const LAS unsigned char* vp, const hf8 (&pa)[4]) {
#pragma unroll
    for (int d0 = 0; d0 < 2; ++d0)
#pragma unroll
        for (int ks = 0; ks < 4; ++ks) { const s16x4 lo = vtr(vp + d0 * 4096 + ks * 1024), hi = vtr(vp + d0 * 4096 + ks * 1024 + 512);
            const hf8 vf = __builtin_bit_cast(hf8, (short __attribute__((ext_vector_type(8)))){lo[0], lo[1], lo[2], lo[3], hi[0], hi[1], hi[2], hi[3]});
            o[d0] = __builtin_amdgcn_mfma_f32_32x32x16_f16(pa[ks], vf, o[d0], 0, 0, 0); }
}
__device__ __forceinline__ void half_pair(float v, float& lo, float& hi) { lo = v; hi = v; asm volatile("s_nop 1\n\tv_permlane32_swap_b32 %0, %1" : "+v"(lo), "+v"(hi)); }
__device__ __forceinline__ float half_swap_max(float m) { float a, b; half_pair(m, a, b); return fmaxf(a, b); }
__device__ __forceinline__ float half_swap_sum(float m) { float a, b; half_pair(m, a, b); return a + b; }
__device__ __forceinline__ void pack4(hf8 (&pa)[4], const f32x16& p0, const f32x16& p1) {
#pragma unroll
    for (int ks = 0; ks < 4; ++ks) { const f32x16& p = (ks < 2) ? p0 : p1; const int o = (ks & 1) * 8;
        u32x4 w; w.x = pkh(p[o + 0], p[o + 1]); w.y = pkh(p[o + 2], p[o + 3]); w.z = pkh(p[o + 4], p[o + 5]); w.w = pkh(p[o + 6], p[o + 7]); pa[ks] = __builtin_bit_cast(hf8, w); }
}
__device__ __forceinline__ void store_o(const f32x16* o, const float* sc, h16* Ow, int pitch, LAS unsigned char* lds, int wid, int lane, int r32, int hi) {
    LAS h16* stg = (LAS h16*)(lds + L_OST) + wid * 2048;
#pragma unroll
    for (int r = 0; r < 16; ++r) { const int orow = crow(r, hi);
#pragma unroll
        for (int d0 = 0; d0 < 2; ++d0) { const _Float16 hv = (_Float16)(o[d0][r] * sc[r]); stg[orow * 64 + d0 * 32 + r32] = __builtin_bit_cast(h16, hv); } }
    LDS_WAIT();
#pragma unroll
    for (int i = 0; i < 4; ++i) { const int row = i * 8 + (lane >> 3), ch = lane & 7; const u32x4 v = *(const LAS u32x4*)(stg + row * 64 + ch * 8); *(u32x4*)(Ow + (size_t)row * pitch + ch * 8) = v; }
}
__device__ __forceinline__ int t5_bucket(int n) {
    if (n < 16) return n;
    const int large = 16 + (int)(__log2f((float)n * (1.0f / 16.0f)) * (16.0f / 3.0f));
    return large < 31 ? large : 31;
}

__device__ __forceinline__ void dsa_unit(const Frame& F, int b, int h, int qb) {
    LAS unsigned char* lds = F.lds + RING_OFF;
    const int tid = F.tid, lane = F.lane, r32 = lane & 31, hi = lane >> 5, wid = F.wave;
    const int q0 = qb * 256; const size_t rowbase = (size_t)b * SEQ;
    const h16* Qw = F.QO() + (rowbase + q0 + wid * 32) * 1024 + h * 64;
    const h16* Kh = F.KA() + rowbase * 512 + h * 64; const h16* Vh = F.VA() + rowbase * 512 + h * 64;
    const unsigned lds0 = (unsigned)(uintptr_t)lds;
    LAS float* wsf = (LAS float*)(lds + L_WS) + wid * 64; LAS float* tbl = (LAS float*)(lds + L_TBL);
    const h16* ksrc = Kh + (size_t)lane * 512 + wid * 8;
    const h16* vsrc = Vh + (size_t)(16 * (wid & 3) + (lane >> 2)) * 512 + (wid >> 2) * 32 + (lane & 3) * 8;
    const unsigned kdst = lds0 + L_K + wid * 1024, vdst = lds0 + L_V + wid * 1024;
#define DMA_KV(t, slot) do { glds16(ksrc + (size_t)(t) * 64 * 512, (unsigned)__builtin_amdgcn_readfirstlane(kdst + (slot))); glds16(vsrc + (size_t)(t) * 64 * 512, (unsigned)__builtin_amdgcn_readfirstlane(vdst + (slot))); } while (0)
    const LAS unsigned char* vp0 = lds + L_V + ((lane >> 4) & 1) * 32 + (lane & 3) * 8 + (4 * hi + ((lane & 15) >> 2)) * 64;
    const int NT = 4 * (qb + 1);
    for (int d = tid; d < 384; d += NWAVES * 64) tbl[d] = F.rel_bias[t5_bucket(d) * 8 + h] * LOG2E;
    const float bias31 = F.rel_bias[31 * 8 + h] * LOG2E;
    DMA_KV(0, 0);
    hf8 qr[4];
#pragma unroll
    for (int d0 = 0; d0 < 4; ++d0) qr[d0] = __builtin_bit_cast(hf8, *(const u32x4*)(Qw + (size_t)r32 * 1024 + d0 * 16 + hi * 8));
    const int tq = q0 + wid * 32 + r32, tqmax = q0 + wid * 32 + 31;
    const unsigned long long* mrow = F.MASK() + (rowbase + tq) * 32;
    float m = -1e30f, l = 0.f; f32x16 o[2]; o[0] = f32x16{}; o[1] = f32x16{};
    const float NINF = -__builtin_inff();
    for (int t = 0; t < NT; ++t) {
        const int slot = (t & 1) * SLOTB;
#ifdef MK_DSA_NOMASK
        const int nvalid_ = tq - 64 * t + 1; const unsigned long long mw = nvalid_ >= 64 ? ~0ull : (nvalid_ <= 0 ? 0ull : ((1ull << nvalid_) - 1ull)); (void)mrow;
#else
        const unsigned long long mw = mrow[t];
#endif
        if (t + 1 < NT) { DMA_KV(t + 1, SLOTB - slot); ATT_WAIT_BAR(2); } else { ATT_WAIT_BAR(0); }
        if (64 * t <= tqmax) {
            const bool band = (t >= NT - 6);
            f32x16 ci; const float c0 = band ? 0.f : bias31;
#pragma unroll
            for (int r = 0; r < 16; ++r) ci[r] = c0;
            f32x16 p0, p1; qkt(p0, p1, lds + L_K + slot, qr, ci, r32, hi);
            if (band) {
#pragma unroll
                for (int r = 0; r < 16; ++r) { const int d0 = tq - (64 * t + crow(r, hi)); const int d1 = d0 - 32; p0[r] += tbl[d0 > 0 ? d0 : 0]; p1[r] += tbl[d1 > 0 ? d1 : 0]; }
            }
            const unsigned wl = (unsigned)mw >> (4 * hi), wh = (unsigned)(mw >> 32) >> (4 * hi);
#pragma unroll
            for (int r = 0; r < 16; ++r) { const int cb = (r & 3) + 8 * (r >> 2); p0[r] = ((wl >> cb) & 1u) ? p0[r] : NINF; p1[r] = ((wh >> cb) & 1u) ? p1[r] : NINF; }
            float rm = fmaxf(p0[0], p1[0]);
#pragma unroll
            for (int r = 1; r < 16; ++r) rm = fmaxf(rm, fmaxf(p0[r], p1[r]));
            rm = half_swap_max(rm);
            if (__any(rm > m + 8.0f)) {
                const float mn = fmaxf(m, rm), f = __builtin_amdgcn_exp2f(m - mn); l *= f; m = mn;
                if (hi == 0) wsf[r32] = f;
                LDS_WAIT();
#pragma unroll
                for (int d_ = 0; d_ < 2; ++d_)
#pragma unroll
                    for (int r = 0; r < 16; ++r) o[d_][r] *= wsf[crow(r, hi)];
            }
            float s = 0.f;
#pragma unroll
            for (int r = 0; r < 16; ++r) { p0[r] = __builtin_amdgcn_exp2f(p0[r] - m); p1[r] = __builtin_amdgcn_exp2f(p1[r] - m); s += p0[r] + p1[r]; }
            l += s;
            hf8 pa[4]; pack4(pa, p0, p1);
            pv(o, vp0 + slot, pa);
        }
        ATT_WAIT_BAR(2);
    }
    l = half_swap_sum(l);
    if (hi == 0) wsf[32 + r32] = l;
    LDS_WAIT();
    float rli[16];
#pragma unroll
    for (int r = 0; r < 16; ++r) rli[r] = 1.0f / wsf[32 + crow(r, hi)];
    store_o(o, rli, const_cast<h16*>(Qw), 1024, lds, wid, lane, r32, hi);
    ATT_WAIT_BAR(0);
#undef DMA_KV
}

__device__ __forceinline__ void sb_unit(const Frame& F, int b, int h, int qb) {
    LAS unsigned char* lds = F.lds + RING_OFF;
    const int lane = F.lane, r32 = lane & 31, hi = lane >> 5, wid = F.wave;
    const int q0 = qb * 256; const size_t rowbase = (size_t)b * SEQ;
    const h16* Qw = F.QO() + (rowbase + q0 + wid * 32) * 1024 + 512 + h * 64;
    const h16* Kh = F.KB() + rowbase * 512 + h * 64; const h16* Vh = F.VB() + rowbase * 512 + h * 64;
    const unsigned lds0 = (unsigned)(uintptr_t)lds;
    LAS unsigned* flag = (LAS unsigned*)(lds + L_FLAG);
    const h16* ksrc = Kh + (size_t)lane * 512 + wid * 8;
    const h16* vsrc = Vh + (size_t)(16 * (wid & 3) + (lane >> 2)) * 512 + (wid >> 2) * 32 + (lane & 3) * 8;
    const unsigned kdst = lds0 + L_K + wid * 1024, vdst = lds0 + L_V + wid * 1024;
#define DMA_KV(t, slot) do { glds16(ksrc + (size_t)(t) * 64 * 512, (unsigned)__builtin_amdgcn_readfirstlane(kdst + (slot))); glds16(vsrc + (size_t)(t) * 64 * 512, (unsigned)__builtin_amdgcn_readfirstlane(vdst + (slot))); } while (0)
    const LAS unsigned char* vp0 = lds + L_V + ((lane >> 4) & 1) * 32 + (lane & 3) * 8 + (4 * hi + ((lane & 15) >> 2)) * 64;
    const int NT = 4 * (qb + 1);
    if (F.tid == 0) flag[0] = 0u;
    DMA_KV(NT - 1, 0);
    hf8 qr[4];
#pragma unroll
    for (int d0 = 0; d0 < 4; ++d0) qr[d0] = __builtin_bit_cast(hf8, *(const u32x4*)(Qw + (size_t)r32 * 1024 + d0 * 16 + hi * 8));
    const int tq = q0 + wid * 32 + r32, tqmax = q0 + wid * 32 + 31;
    float R = 0.f; f32x16 o[2]; o[0] = f32x16{}; o[1] = f32x16{};
    bool done = false; int it = 0;
    for (int t = NT - 1; t >= 0; --t, ++it) {
        const int slot = (it & 1) * SLOTB;
        if (t > 0) { DMA_KV(t - 1, SLOTB - slot); ATT_WAIT_BAR(2); } else { ATT_WAIT_BAR(0); }
        if (!done && 64 * t < tqmax) {
            f32x16 ci = f32x16{}; f32x16 p0, p1; qkt(p0, p1, lds + L_K + slot, qr, ci, r32, hi);
            f32x16 s0, s1;
#pragma unroll
            for (int r = 0; r < 16; ++r) { const int key = 64 * t + crow(r, hi);
                { const float z = p0[r]; const float tt = __builtin_amdgcn_logf(1.0f + __builtin_amdgcn_exp2f(-fabsf(z))); s0[r] = (key < tq) ? fmaxf(z, 0.f) + tt : 0.f; p0[r] = fminf(z, 0.f) - tt; }
                { const float z = p1[r]; const float tt = __builtin_amdgcn_logf(1.0f + __builtin_amdgcn_exp2f(-fabsf(z))); s1[r] = (key + 32 < tq) ? fmaxf(z, 0.f) + tt : 0.f; p1[r] = fminf(z, 0.f) - tt; } }
            float T[8], ex[8];
#pragma unroll
            for (int g = 0; g < 8; ++g) { const f32x16& s = (g < 4) ? s0 : s1; const int rb = 4 * (g & 3); const float gsum = (s[rb] + s[rb + 1]) + (s[rb + 2] + s[rb + 3]);
                float slo, shi; half_pair(gsum, slo, shi); T[g] = slo + shi; ex[g] = hi ? 0.f : shi; }
            float suf[8]; suf[7] = 0.f;
#pragma unroll
            for (int g = 6; g >= 0; --g) suf[g] = suf[g + 1] + T[g + 1];
            const float total = suf[0] + T[0];
#pragma unroll
            for (int g = 0; g < 8; ++g) { float run = R + suf[g] + ex[g];
#pragma unroll
                for (int i = 3; i >= 0; --i) { const int r = 4 * (g & 3) + i; const int key = 64 * t + ((g < 4) ? 0 : 32) + crow(r, hi);
                    if (g < 4) { const float lsig = p0[r]; p0[r] = (key < tq) ? __builtin_amdgcn_exp2f(lsig - run) : 0.f; run += s0[r]; }
                    else { const float lsig = p1[r]; p1[r] = (key < tq) ? __builtin_amdgcn_exp2f(lsig - run) : 0.f; run += s1[r]; } } }
            R += total;
            hf8 pa[4]; pack4(pa, p0, p1);
            pv(o, vp0 + slot, pa);
            if (__all(R > 160.0f)) { done = true; if (lane == 0) __hip_atomic_fetch_add(flag, 1u, __ATOMIC_RELAXED, __HIP_MEMORY_SCOPE_WORKGROUP); }
        }
        ATT_WAIT_BAR(2);
        if (flag[0] >= (unsigned)NWAVES) break;
    }
    asm volatile("s_waitcnt vmcnt(0)" ::: "memory");
    float one[16];
#pragma unroll
    for (int r = 0; r < 16; ++r) one[r] = 1.0f;
    store_o(o, one, const_cast<h16*>(Qw), 1024, lds, wid, lane, r32, hi);
    ATT_WAIT_BAR(0);
#undef DMA_KV
}

__device__ __forceinline__ void dsa_naive_phase(const Frame& F) {
    const int gt = (F.vcu * NWAVES + F.wave) * 64 + F.lane, NT_ = F.G * NWAVES * 64;
    for (int item = gt; item < M * 8; item += NT_) {
        const int h = item & 7, row = item >> 3, b = row / SEQ, t = row % SEQ; const size_t rowbase = (size_t)b * SEQ;
        float q[64], o[64];
        { const h16* qp = F.QO() + (size_t)row * 1024 + h * 64;
#pragma unroll
          for (int c = 0; c < 8; ++c) { const hf8 v = __builtin_bit_cast(hf8, *(const u32x4*)(qp + 8 * c));
#pragma unroll
              for (int e = 0; e < 8; ++e) { q[8 * c + e] = (float)v[e]; o[8 * c + e] = 0.f; } } }
        float m = -1e30f, l = 0.f;
        const unsigned long long* mrow = F.MASK() + (size_t)row * 32;
        for (int s = 0; s <= t; ++s) {
            if (!((mrow[s >> 6] >> (s & 63)) & 1ull)) continue;
            const h16* kp = F.KA() + (rowbase + s) * 512 + h * 64; const h16* vp = F.VA() + (rowbase + s) * 512 + h * 64;
            float dot = 0.f;
#pragma unroll
            for (int c = 0; c < 8; ++c) { const hf8 v = __builtin_bit_cast(hf8, *(const u32x4*)(kp + 8 * c));
#pragma unroll
                for (int e = 0; e < 8; ++e) dot += q[8 * c + e] * (float)v[e]; }
            const float lg = dot + F.rel_bias[t5_bucket(t - s) * 8 + h] * LOG2E;
            if (lg > m) { const float f = __builtin_amdgcn_exp2f(m - lg); l *= f;
#pragma unroll
                for (int d = 0; d < 64; ++d) o[d] *= f;
                m = lg; }
            const float p = __builtin_amdgcn_exp2f(lg - m); l += p;
#pragma unroll
            for (int c = 0; c < 8; ++c) { const hf8 v = __builtin_bit_cast(hf8, *(const u32x4*)(vp + 8 * c));
#pragma unroll
                for (int e = 0; e < 8; ++e) o[8 * c + e] += p * (float)v[e]; }
        }
        const float il = 1.0f / l; h16* op = F.QO() + (size_t)row * 1024 + h * 64;
#pragma unroll
        for (int c = 0; c < 8; ++c) { u32x4 w; w.x = pkh(o[8 * c] * il, o[8 * c + 1] * il); w.y = pkh(o[8 * c + 2] * il, o[8 * c + 3] * il); w.z = pkh(o[8 * c + 4] * il, o[8 * c + 5] * il); w.w = pkh(o[8 * c + 6] * il, o[8 * c + 7] * il);
            *(u32x4*)(op + 8 * c) = w; }
    }
}

__device__ __forceinline__ void sb_naive_phase(const Frame& F) {
    const int gt = (F.vcu * NWAVES + F.wave) * 64 + F.lane, NT_ = F.G * NWAVES * 64;
    for (int item = gt; item < M * 8; item += NT_) {
        const int h = item & 7, row = item >> 3, b = row / SEQ, t = row % SEQ; const size_t rowbase = (size_t)b * SEQ;
        float q[64], o[64];
        { const h16* qp = F.QO() + (size_t)row * 1024 + 512 + h * 64;
#pragma unroll
          for (int c = 0; c < 8; ++c) { const hf8 v = __builtin_bit_cast(hf8, *(const u32x4*)(qp + 8 * c));
#pragma unroll
              for (int e = 0; e < 8; ++e) { q[8 * c + e] = (float)v[e]; o[8 * c + e] = 0.f; } } }
        float R = 0.f;
        for (int s = t - 1; s >= 0 && R < 120.f; --s) {
            const h16* kp = F.KB() + (rowbase + s) * 512 + h * 64; const h16* vp = F.VB() + (rowbase + s) * 512 + h * 64;
            float dot = 0.f;
#pragma unroll
            for (int c = 0; c < 8; ++c) { const hf8 v = __builtin_bit_cast(hf8, *(const u32x4*)(kp + 8 * c));
#pragma unroll
                for (int e = 0; e < 8; ++e) dot += q[8 * c + e] * (float)v[e]; }
            const float z = dot * (1.0f / LOG2E);
            const float sp = fmaxf(z, 0.f) + log1pf(expf(-fabsf(z)));
            const float a = expf((z - sp) - R);
            R += sp;
#pragma unroll
            for (int c = 0; c < 8; ++c) { const hf8 v = __builtin_bit_cast(hf8, *(const u32x4*)(vp + 8 * c));
#pragma unroll
                for (int e = 0; e < 8; ++e) o[8 * c + e] += a * (float)v[e]; }
        }
        h16* op = F.QO() + (size_t)row * 1024 + 512 + h * 64;
#pragma unroll
        for (int c = 0; c < 8; ++c) { u32x4 w; w.x = pkh(o[8 * c], o[8 * c + 1]); w.y = pkh(o[8 * c + 2], o[8 * c + 3]); w.z = pkh(o[8 * c + 4], o[8 * c + 5]); w.w = pkh(o[8 * c + 6], o[8 * c + 7]);
            *(u32x4*)(op + 8 * c) = w; }
    }
}
__device__ __forceinline__ void att_phase(const Frame& F) {
    for (int i = 0; ; ++i) { const int u = i * F.G + F.vcu; if (u >= 1024) break; const int rnd = u >> 8, c = u & 255, bh = c >> 1, sub = c & 1;
        const int qb = (rnd == 0) ? sub : (rnd == 1) ? 7 - sub : (rnd == 2) ? 2 + sub : 5 - sub;
#if !defined(MK_SKIP_DSA) && !defined(MK_NAIVE_DSA)
        dsa_unit(F, bh >> 3, bh & 7, qb);
#endif
    }
#ifdef MK_NAIVE_DSA
    dsa_naive_phase(F);
#endif
#ifdef MK_NAIVE_SB
    sb_naive_phase(F);
#endif
    for (int i = 0; ; ++i) { const int u = i * F.G + F.vcu; if (u >= 1024) break; const int rnd = u >> 8, c = u & 255, bh = c >> 1, sub = c & 1;
#if !defined(MK_SKIP_SB) && !defined(MK_NAIVE_SB)
        sb_unit(F, bh >> 3, bh & 7, 4 * sub + rnd);
#endif
    }
}
}

struct Args { const float* in[15]; float* out; unsigned char* ws; int ph_lo, ph_hi, li, pad; };
__global__ void __launch_bounds__(NWAVES * 64, 2) mk_fwd(Args args) {
    extern __shared__ __attribute__((aligned(16))) unsigned char lds_raw[];
    Frame F;
    F.lds = (LAS unsigned char*)lds_raw;
    volatile LAS unsigned* MISC = (volatile LAS unsigned*)(F.lds + MISC_OFF);
    F.tid = threadIdx.x; F.lane = F.tid & 63; F.wave = __builtin_amdgcn_readfirstlane(F.tid >> 6);
    F.G = gridDim.x; { const int bx = blockIdx.x; F.vcu = (F.G % 8 == 0) ? (bx % 8) * (F.G / 8) + bx / 8 : bx; }
    unsigned char* ws = args.ws;
    gu32* ctl = (gu32*)(ws + WS_CTL);
    F.x = args.in[0]; F.c = args.in[1]; F.w_ada = args.in[2]; F.b_ada = args.in[3]; F.g_pre = args.in[4]; F.g_post = args.in[5]; F.w_gate = args.in[6]; F.w_up = args.in[7]; F.w_down = args.in[8];
    F.w_in = args.in[9]; F.g_kidx = args.in[10]; F.rel_bias = args.in[11]; F.g_out_a = args.in[12]; F.g_out_b = args.in[13]; F.w_out = args.in[14]; F.out = args.out;
    F.ws = ws;
    for (int u = F.tid; u < (LDS_BYTES - LDSCTL_OFF) / 4; u += NWAVES * 64) ((LAS unsigned*)(F.lds + LDSCTL_OFF))[u] = 0u;
    __syncthreads();
    XcdBarrier bar; bar.bar = (unsigned*)(ctl + CW_BAR); bar.x = 0; bar.st = nullptr;
    if (N_LAUNCHES == 1) bar = xcd_barrier_post((unsigned*)(ctl + CW_BAR), MISC + 8);
#define GRID_BAR() do { if (N_LAUNCHES == 1) xcd_barrier(bar); } while (0)
    const int lo = args.ph_lo, hi = args.ph_hi;
#define IN(k) (lo <= (k) && (k) < hi)
#define SEAM(k) do { if (IN((k) + 1)) GRID_BAR(); } while (0)

    if (IN(0)) { p0_prologue(F); SEAM(0); }
    if (IN(1)) { prenorm_phase(F, F.x, 0); SEAM(1); }
    if (IN(2)) { pg8::Gemm g{F.XN(), F.Wgu(0), M, NGU, D}; pg8::StaticOrder S; S.init(M, NGU, F.G, (int)blockIdx.x); pg8::EpiSwiGLU E{F.H()};
        pg8::gemm_phase<pg8::EpiSwiGLU, pg8::StaticOrder>(F.lds + RING_OFF, g, S, E); SEAM(2); }
    if (IN(3)) { pg8::Gemm g{F.H(), F.Wd(0), M, D, FF}; pg8::StaticOrder S; S.init(M, D, F.G, (int)blockIdx.x); pg8::EpiF32 E{F.out, D};
        pg8::gemm_phase<pg8::EpiF32, pg8::StaticOrder>(F.lds + RING_OFF, g, S, E); SEAM(3); }
    if (IN(4)) { resnorm_phase(F, F.out, F.x, F.H1(), 0, 0.5f, 1); SEAM(4); }
    if (IN(5)) { pg8::Gemm g{F.XN(), F.Win(), M, NINP, D}; pg8::StaticOrder S; S.init(M, NINP, F.G, (int)blockIdx.x); pg8::EpiInProj E{F.QO(), F.KA(), F.VA(), F.QI(), F.KB(), F.VB(), F.KI(), F.WI(), F.g_kidx};
        pg8::gemm_phase<pg8::EpiInProj, pg8::StaticOrder>(F.lds + RING_OFF, g, S, E); SEAM(5); }
#ifdef MK_NAIVE_IDX
    if (IN(6)) { idx_naive_phase(F); SEAM(6); }
#else
    if (IN(6)) { idx_phase(F); SEAM(6); }
#endif
    if (IN(7)) { att::att_phase(F); SEAM(7); }
    if (IN(8)) { onorm_phase(F); SEAM(8); }
    if (IN(9)) { pg8::Gemm g{F.QO(), F.Wout(), M, D, D}; pg8::StaticOrder S; S.init(M, D, F.G, (int)blockIdx.x); pg8::EpiF32 E{F.out, D};
        pg8::gemm_phase<pg8::EpiF32, pg8::StaticOrder>(F.lds + RING_OFF, g, S, E); SEAM(9); }
    if (IN(10)) { resnorm_phase(F, F.out, F.H1(), F.H1(), 1, 1.0f, 2); SEAM(10); }
    if (IN(11)) { pg8::Gemm g{F.XN(), F.Wgu(1), M, NGU, D}; pg8::StaticOrder S; S.init(M, NGU, F.G, (int)blockIdx.x); pg8::EpiSwiGLU E{F.H()};
        pg8::gemm_phase<pg8::EpiSwiGLU, pg8::StaticOrder>(F.lds + RING_OFF, g, S, E); SEAM(11); }
    if (IN(12)) { pg8::Gemm g{F.H(), F.Wd(1), M, D, FF}; pg8::StaticOrder S; S.init(M, D, F.G, (int)blockIdx.x); pg8::EpiF32 E{F.out, D};
        pg8::gemm_phase<pg8::EpiF32, pg8::StaticOrder>(F.lds + RING_OFF, g, S, E); SEAM(12); }
    if (IN(13)) { resnorm_phase(F, F.out, F.H1(), F.out, 2, 0.5f, -1); }
    if (args.ph_lo >= 100) {
        const int gw = F.vcu * NWAVES + F.wave, NGW = F.G * NWAVES;
        for (int r = gw; r < M; r += NGW) { GAS f32x4* d = (GAS f32x4*)(F.out + (size_t)r * D) + F.lane;
            if (args.ph_lo == 100) { const GAS f32x4* s = (const GAS f32x4*)(F.H1() + (size_t)r * D) + F.lane;
#pragma unroll
                for (int j = 0; j < 4; ++j) d[64 * j] = s[64 * j]; }
            else { const GAS u32x2* s = (const GAS u32x2*)(F.QO() + (size_t)r * D) + F.lane;
#pragma unroll
                for (int j = 0; j < 4; ++j) { const u32x2 w = s[64 * j]; const hf2 a = __builtin_bit_cast(hf2, w.x), b = __builtin_bit_cast(hf2, w.y); d[64 * j] = (f32x4){(float)a[0], (float)a[1], (float)b[0], (float)b[1]}; } }
        }
    }
#undef IN
#undef SEAM
#undef GRID_BAR
}

extern "C" void kernel_launch(void* const* d_in, const int* in_sizes, int n_in, void* d_out, int out_size, void* d_ws, size_t ws_size, hipStream_t stream) {
    static int grid = 0;
    if (grid == 0) {
        if (n_in != 15 || in_sizes[0] != M * D || out_size != M * D || ws_size < WS_END) { fprintf(stderr, "kernel_launch: unexpected shapes (n_in %d, in0 %d, out %d, ws %zu); nothing launched\n", n_in, n_in > 0 ? in_sizes[0] : -1, out_size, ws_size); grid = -1; return; }
        int dev = 0, cus = 0, per_cu = 0;
        if (hipGetDevice(&dev) != hipSuccess || hipDeviceGetAttribute(&cus, hipDeviceAttributeMultiprocessorCount, dev) != hipSuccess) { grid = -1; return; }
        if (hipFuncSetAttribute((const void*)mk_fwd, hipFuncAttributeMaxDynamicSharedMemorySize, LDS_BYTES) != hipSuccess) { fprintf(stderr, "kernel_launch: hipFuncSetAttribute failed\n"); grid = -1; return; }
        if (hipOccupancyMaxActiveBlocksPerMultiprocessor(&per_cu, (const void*)mk_fwd, NWAVES * 64, LDS_BYTES) != hipSuccess || per_cu < 1) fprintf(stderr, "kernel_launch: occupancy query reports %d\n", per_cu);
        (void)hipGetLastError();
        grid = cus;
    }
    if (grid < 0) return;
    if (hipMemsetAsync((char*)d_ws + WS_CTL, 0, CTL_ZERO_BYTES, stream) != hipSuccess) return;
    Args a{};
    for (int i = 0; i < 15; ++i) a.in[i] = (const float*)d_in[i];
    a.out = (float*)d_out; a.ws = (unsigned char*)d_ws;
    for (int li = 0; li < N_LAUNCHES; ++li) {
        a.ph_lo = (N_LAUNCHES == 1) ? 0 : li; a.ph_hi = (N_LAUNCHES == 1) ? NPHASE : li + 1; a.li = li;
        if (li > MK_DEBUG_STOP) { a.ph_lo = MK_DEBUG_MODE; a.ph_hi = MK_DEBUG_MODE + 1; }
        hipLaunchKernelGGL(mk_fwd, dim3(grid), dim3(NWAVES * 64), LDS_BYTES, stream, a);
        if (li > MK_DEBUG_STOP) break;
    }
}
```

```cpp
#include <hip/hip_runtime.h>
#include <cstdio>
#include <cstdint>
#include <cmath>

#define LAS __attribute__((address_space(3)))
#define GAS __attribute__((address_space(1)))
typedef unsigned short h16;
typedef _Float16 hf8 __attribute__((ext_vector_type(8)));
typedef _Float16 hf2 __attribute__((ext_vector_type(2)));
typedef float f32x2 __attribute__((ext_vector_type(2)));
typedef float f32x4 __attribute__((ext_vector_type(4)));
typedef float f32x16 __attribute__((ext_vector_type(16)));
typedef unsigned u32x2 __attribute__((ext_vector_type(2)));
typedef unsigned u32x4 __attribute__((ext_vector_type(4)));
typedef short s16x4 __attribute__((ext_vector_type(4)));
typedef short v4i16_t __attribute__((ext_vector_type(4)));

__device__ __forceinline__ unsigned pkh(float lo, float hi) { f32x2 v = {lo, hi}; hf2 h = __builtin_convertvector(v, hf2); return __builtin_bit_cast(unsigned, h); }

constexpr int NB = 16, SEQ = 2048, M = NB * SEQ, D = 1024, FF = 2816, NGU = 2 * FF, NINP = 3840, INCOLS = 3656, NMOD = 9 * D;
constexpr float EPS = 1e-6f;
constexpr float LOG2E = 1.4426950408889634f;
constexpr float C2 = 0.125f * LOG2E;

namespace pg8 {
constexpr int BM = 256, BK = 64, HALF = 128, HTB = HALF * BK * 2, STAGE_BYTES = 8 * HTB, NXCD = 8, WGM = 8;
__host__ __device__ __forceinline__ int lds_byte(int r, int c) { const int st = (r >> 4) * 2 + (c >> 5), rr = r & 15, cc = c & 31, ob = rr * 64 + cc * 2; return st * 1024 + (ob ^ (((ob >> 9) & 1) << 5)); }
__host__ __device__ __forceinline__ void stage_rc(int b, int& R, int& C) { const int st = b / 1024, sb = b % 1024, swz = sb ^ (((sb >> 9) & 1) << 5); R = (st >> 1) * 16 + swz / 64; C = (st & 1) * 32 + (swz % 64) / 2; }
__host__ __device__ __forceinline__ int perm32(int rho) { const int n = rho >> 4, i = rho & 15; return 8 * (i >> 2) + 4 * n + (i & 3); }
struct Unit { int pm, pn; };
struct Gemm { const h16* A; const h16* Bt; int M, N, K; };
struct StaticOrder {
    int nM, nN, nwg, G, c;
    __host__ __device__ void init(int M_, int N_, int G_, int c_) { nM = M_ / BM; nN = N_ / BM; nwg = nM * nN; G = G_; c = c_; }
    __host__ __device__ bool next(int i, Unit& u) const {
        const long L = (long)i * G + c; if (L >= nwg) return false;
        int wgid = (int)L; { const int q = nwg / NXCD, r = nwg % NXCD, xcd = wgid % NXCD, off = wgid / NXCD; wgid = (xcd < r ? xcd * (q + 1) : r * (q + 1) + (xcd - r) * q) + off; }
        const int nig = WGM * nN, gid = wgid / nig, fm = gid * WGM, gsz = (nM - fm) < WGM ? (nM - fm) : WGM;
        u.pm = fm + ((wgid % nig) % gsz); u.pn = (wgid % nig) / gsz; return true;
    }
    __device__ __forceinline__ void a_ready(const Unit&) const {}
    __device__ __forceinline__ void done(const Unit&) const {}
};
__device__ __forceinline__ float silu_mul(float g, float u) { const float e = __builtin_amdgcn_exp2f(-g * LOG2E); return g * u * __builtin_amdgcn_rcpf(1.0f + e); }
struct EpiSwiGLU {
    static constexpr bool PERM = true;
    h16* H;
    __device__ __forceinline__ void operator()(const f32x4 (&acc)[2][2][4][2], const Unit& u, int wr, int wc, int fr, int fq) const {
        const int row0 = u.pm * BM + wr * 64 + fr, col0 = u.pn * HALF + wc * 32 + 8 * fq;
#pragma unroll
        for (int ai = 0; ai < 2; ++ai)
#pragma unroll
            for (int m = 0; m < 4; ++m) {
                const f32x4 g0 = acc[ai][0][m][0], g1 = acc[ai][0][m][1], u0 = acc[ai][1][m][0], u1 = acc[ai][1][m][1];
                u32x4 w; w.x = pkh(silu_mul(g0[0], u0[0]), silu_mul(g0[1], u0[1])); w.y = pkh(silu_mul(g0[2], u0[2]), silu_mul(g0[3], u0[3]));
                w.z = pkh(silu_mul(g1[0], u1[0]), silu_mul(g1[1], u1[1])); w.w = pkh(silu_mul(g1[2], u1[2]), silu_mul(g1[3], u1[3]));
                *(u32x4*)(H + (size_t)(row0 + ai * HALF + m * 16) * FF + col0) = w; }
    }
};
struct EpiF32 {
    static constexpr bool PERM = false;
    float* O; int ldc;
    __device__ __forceinline__ void operator()(const f32x4 (&acc)[2][2][4][2], const Unit& u, int wr, int wc, int fr, int fq) const {
        const int row0 = u.pm * BM + wr * 64 + fr, col0 = u.pn * BM + wc * 32 + 4 * fq;
#pragma unroll
        for (int ai = 0; ai < 2; ++ai)
#pragma unroll
            for (int m = 0; m < 4; ++m) { float* rowp = O + (size_t)(row0 + ai * HALF + m * 16) * ldc + col0;
#pragma unroll
                for (int bj = 0; bj < 2; ++bj)
#pragma unroll
                    for (int n = 0; n < 2; ++n) *(f32x4*)(rowp + bj * HALF + n * 16) = acc[ai][bj][m][n]; }
    }
};
struct EpiF16 {
    static constexpr bool PERM = true;
    h16* O; int ldc;
    __device__ __forceinline__ void operator()(const f32x4 (&acc)[2][2][4][2], const Unit& u, int wr, int wc, int fr, int fq) const {
        const int row0 = u.pm * BM + wr * 64 + fr, col0 = u.pn * BM + wc * 32 + 8 * fq;
#pragma unroll
        for (int ai = 0; ai < 2; ++ai)
#pragma unroll
            for (int m = 0; m < 4; ++m) { h16* rowp = O + (size_t)(row0 + ai * HALF + m * 16) * ldc + col0;
#pragma unroll
                for (int bj = 0; bj < 2; ++bj) { const f32x4 v0 = acc[ai][bj][m][0], v1 = acc[ai][bj][m][1];
                    u32x4 w; w.x = pkh(v0[0], v0[1]); w.y = pkh(v0[2], v0[3]); w.z = pkh(v1[0], v1[1]); w.w = pkh(v1[2], v1[3]);
                    *(u32x4*)(rowp + bj * HALF) = w; } }
    }
};
struct EpiInProj {
    static constexpr bool PERM = true;
    h16 *QO, *KA, *VA, *QI, *KB, *VB, *KI; float* WI; const float* gk;
    __device__ __forceinline__ void operator()(const f32x4 (&acc)[2][2][4][2], const Unit& u, int wr, int wc, int fr, int fq) const {
        const int row0 = u.pm * BM + wr * 64 + fr;
        if (u.pn < 14) {
            const int sel = u.pn >> 1; h16* base; int ld = 512, coff = (u.pn & 1) * 256; float sc = 1.0f;
            if (sel == 0) { base = QO; ld = 1024; sc = C2; } else if (sel == 1) { base = QO; ld = 1024; coff += 512; sc = C2; }
            else if (sel == 2) base = KA; else if (sel == 3) base = VA; else if (sel == 4) base = QI; else if (sel == 5) base = KB; else base = VB;
            const int col0 = coff + wc * 32 + 8 * fq;
#pragma unroll
            for (int ai = 0; ai < 2; ++ai)
#pragma unroll
                for (int m = 0; m < 4; ++m) { h16* rowp = base + (size_t)(row0 + ai * HALF + m * 16) * ld + col0;
#pragma unroll
                    for (int bj = 0; bj < 2; ++bj) { const f32x4 v0 = acc[ai][bj][m][0] * sc, v1 = acc[ai][bj][m][1] * sc;
                        u32x4 w; w.x = pkh(v0[0], v0[1]); w.y = pkh(v0[2], v0[3]); w.z = pkh(v1[0], v1[1]); w.w = pkh(v1[2], v1[3]);
                        *(u32x4*)(rowp + bj * HALF) = w; } }
        } else if (wc == 0) {
            f32x4 g[2][2];
#pragma unroll
            for (int bj = 0; bj < 2; ++bj)
#pragma unroll
                for (int n = 0; n < 2; ++n) g[bj][n] = *(const f32x4*)(gk + bj * 32 + 8 * fq + 4 * n);
#pragma unroll
            for (int ai = 0; ai < 2; ++ai)
#pragma unroll
                for (int m = 0; m < 4; ++m) { float ss = 0.f;
#pragma unroll
                    for (int bj = 0; bj < 2; ++bj)
#pragma unroll
                        for (int n = 0; n < 2; ++n) { const f32x4 x = acc[ai][bj][m][n]; ss += (x[0] * x[0] + x[1] * x[1]) + (x[2] * x[2] + x[3] * x[3]); }
                    ss += __shfl_xor(ss, 16); ss += __shfl_xor(ss, 32);
                    const float rstd = 1.0f / sqrtf(ss * (1.0f / 64.0f) + EPS);
                    h16* rowp = KI + (size_t)(row0 + ai * HALF + m * 16) * 64 + 8 * fq;
#pragma unroll
                    for (int bj = 0; bj < 2; ++bj) { const f32x4 v0 = acc[ai][bj][m][0] * rstd * g[bj][0], v1 = acc[ai][bj][m][1] * rstd * g[bj][1];
                        u32x4 w; w.x = pkh(v0[0], v0[1]); w.y = pkh(v0[2], v0[3]); w.z = pkh(v1[0], v1[1]); w.w = pkh(v1[2], v1[3]);
                        *(u32x4*)(rowp + bj * 32) = w; } }
        } else if (wc == 1 && fq == 0) {
            const float ws = 0.044194173824159216f;
#pragma unroll
            for (int ai = 0; ai < 2; ++ai)
#pragma unroll
                for (int m = 0; m < 4; ++m) { float* rowp = WI + (size_t)(row0 + ai * HALF + m * 16) * 8;
                    *(f32x4*)rowp = acc[ai][0][m][0] * ws; *(f32x4*)(rowp + 4) = acc[ai][0][m][1] * ws; }
        }
    }
};

template <class Epi, class Sched>
__device__ __forceinline__ void gemm_phase(LAS unsigned char* lds, const Gemm g, const Sched& S, const Epi& E) {
    const int tid = threadIdx.x, wid = __builtin_amdgcn_readfirstlane(tid >> 6), lane = tid & 63, wr = wid >> 2, wc = wid & 3, fr = lane & 15, fq = lane >> 4;
    const int K = g.K, nt = K / BK;
    unsigned voffA[2], voffB[2];
#pragma unroll
    for (int i = 0; i < 2; ++i) { int R, C; stage_rc(tid * 16 + i * 8192, R, C); const int Rb = Epi::PERM ? ((R & ~31) + perm32(R & 31)) : R;
        voffA[i] = (unsigned)(R * K + C) * 2u; voffB[i] = (unsigned)(Rb * K + C) * 2u; }
    const size_t kstep = (size_t)(BK * 2);
    const size_t hstep = (size_t)HALF * K * 2;
    const size_t tstep = 2 * hstep;
    const unsigned ldsw = (unsigned)wid * 1024u;
    const int aoff = lds_byte(wr * 64 + fr, fq * 8), boff = lds_byte(wc * 32 + fr, fq * 8);
#define PG8_SA(b, h) (((b) * 2 + (h)) * HTB)
#define PG8_SB(b, h) ((4 + (b) * 2 + (h)) * HTB)
#define PG8_STAGE(bufoff, gbase, voff) do { _Pragma("unroll") for (int _i = 0; _i < 2; ++_i) \
        __builtin_amdgcn_global_load_lds((const unsigned*)((const char*)(gbase) + (voff)[_i]), (LAS unsigned*)(lds + (bufoff) + ldsw + _i * 8192), 16, 0, 0); } while (0)
#define PG8_LDA(dst, b, h) do { _Pragma("unroll") for (int m = 0; m < 4; ++m) _Pragma("unroll") for (int k = 0; k < 2; ++k) dst[m][k] = *(const LAS hf8*)(lds + PG8_SA(b, h) + aoff + m * 2048 + k * 1024); } while (0)
#define PG8_LDB(dst, b, h) do { _Pragma("unroll") for (int n = 0; n < 2; ++n) _Pragma("unroll") for (int k = 0; k < 2; ++k) dst[n][k] = *(const LAS hf8*)(lds + PG8_SB(b, h) + boff + n * 2048 + k * 1024); } while (0)
#define PG8_MMA(ai, bj, At, Bt) do { __builtin_amdgcn_s_setprio(1); _Pragma("unroll") for (int m = 0; m < 4; ++m) _Pragma("unroll") for (int n = 0; n < 2; ++n) _Pragma("unroll") for (int k = 0; k < 2; ++k) \
        acc[ai][bj][m][n] = __builtin_amdgcn_mfma_f32_16x16x32_f16(Bt[n][k], At[m][k], acc[ai][bj][m][n], 0, 0, 0); __builtin_amdgcn_s_setprio(0); } while (0)
#define PG8_WAIT_V(n) asm volatile("s_waitcnt vmcnt(" #n ")" ::: "memory")
#define PG8_WAIT_L(n) asm volatile("s_waitcnt lgkmcnt(" #n ")" ::: "memory")
#define PG8_BAR __builtin_amdgcn_s_barrier()
#define PG8_SCHED __builtin_amdgcn_sched_barrier(0)
    Unit cur, nxt; int ui = 0;
    if (!S.next(0, cur)) return;
    f32x4 acc[2][2][4][2];
#pragma unroll
    for (int a = 0; a < 2; ++a)
#pragma unroll
        for (int b = 0; b < 2; ++b)
#pragma unroll
            for (int m = 0; m < 4; ++m)
#pragma unroll
                for (int n = 0; n < 2; ++n) acc[a][b][m][n] = (f32x4){0.f, 0.f, 0.f, 0.f};
    hf8 At[4][2], B0[2][2], B1[2][2];
    const char* cA = (const char*)g.A + (size_t)cur.pm * tstep; const char* cB = (const char*)g.Bt + (size_t)cur.pn * tstep;
    S.a_ready(cur);
    PG8_STAGE(PG8_SB(0, 0), cB, voffB); PG8_STAGE(PG8_SB(0, 1), cB + hstep, voffB); PG8_STAGE(PG8_SA(0, 0), cA, voffA); PG8_STAGE(PG8_SA(0, 1), cA + hstep, voffA);
    if (wr == 1) PG8_BAR;
    PG8_WAIT_V(2); PG8_BAR;
    PG8_STAGE(PG8_SB(1, 0), cB + kstep, voffB); PG8_STAGE(PG8_SA(1, 0), cA + kstep, voffA); PG8_STAGE(PG8_SB(1, 1), cB + hstep + kstep, voffB);
    PG8_WAIT_V(6); PG8_BAR;
    for (;;) {
        const bool has_next = S.next(ui + 1, nxt);
        const char* nA = has_next ? (const char*)g.A + (size_t)nxt.pm * tstep : cA; const char* nB = has_next ? (const char*)g.Bt + (size_t)nxt.pn * tstep : cB;
        for (int t = 0; t < nt; t += 2) {
            const bool last = (t == nt - 2);
            const char* a1 = cA + (size_t)(t + 1) * kstep;
            const char* a2 = last ? nA : cA + (size_t)(t + 2) * kstep; const char* b2 = last ? nB : cB + (size_t)(t + 2) * kstep;
            const char* a3 = a2 + kstep; const char* b3 = b2 + kstep;
            if (last && has_next) S.a_ready(nxt);
            PG8_LDB(B0, 0, 0); PG8_LDB(B1, 0, 1); PG8_SCHED; PG8_LDA(At, 0, 0); PG8_STAGE(PG8_SA(1, 1), a1 + hstep, voffA);
            PG8_WAIT_V(8); PG8_WAIT_L(0); PG8_BAR; PG8_MMA(0, 0, At, B0); PG8_MMA(0, 1, At, B1); PG8_BAR; PG8_SCHED;
            PG8_LDA(At, 0, 1); PG8_STAGE(PG8_SB(0, 0), b2, voffB); PG8_STAGE(PG8_SB(0, 1), b2 + hstep, voffB); PG8_STAGE(PG8_SA(0, 0), a2, voffA);
            PG8_WAIT_V(8); PG8_WAIT_L(0); PG8_BAR; PG8_MMA(1, 0, At, B0); PG8_MMA(1, 1, At, B1); PG8_BAR; PG8_SCHED;
            PG8_LDB(B0, 1, 0); PG8_LDB(B1, 1, 1); PG8_SCHED; PG8_LDA(At, 1, 0); PG8_STAGE(PG8_SA(0, 1), a2 + hstep, voffA);
            PG8_WAIT_V(8); PG8_WAIT_L(0); PG8_BAR; PG8_MMA(0, 0, At, B0); PG8_MMA(0, 1, At, B1); PG8_BAR; PG8_SCHED;
            PG8_LDA(At, 1, 1); PG8_STAGE(PG8_SB(1, 0), b3, voffB); PG8_STAGE(PG8_SB(1, 1), b3 + hstep, voffB); PG8_STAGE(PG8_SA(1, 0), a3, voffA);
            PG8_WAIT_V(8); PG8_WAIT_L(0); PG8_BAR; PG8_MMA(1, 0, At, B0); PG8_MMA(1, 1, At, B1); PG8_BAR; PG8_SCHED;
        }
        if (wr == 0) PG8_BAR;
        E(acc, cur, wr, wc, fr, fq); S.done(cur);
        if (!has_next) break;
#pragma unroll
        for (int a = 0; a < 2; ++a)
#pragma unroll
            for (int b = 0; b < 2; ++b)
#pragma unroll
                for (int m = 0; m < 4; ++m)
#pragma unroll
                    for (int n = 0; n < 2; ++n) acc[a][b][m][n] = (f32x4){0.f, 0.f, 0.f, 0.f};
        cur = nxt; cA = nA; cB = nB; ++ui;
        if (wr == 1) PG8_BAR;
    }
    PG8_WAIT_V(0);
    PG8_BAR;
#undef PG8_SA
#undef PG8_SB
#undef PG8_STAGE
#undef PG8_LDA
#undef PG8_LDB
#undef PG8_MMA
#undef PG8_WAIT_V
#undef PG8_WAIT_L
#undef PG8_BAR
#undef PG8_SCHED
}
}

constexpr int NWAVES = 8;
constexpr int NPHASE = 14;
#ifndef MK_N_LAUNCHES
#define MK_N_LAUNCHES 1
#endif
constexpr int N_LAUNCHES = MK_N_LAUNCHES;
#ifndef MK_REPEAT
#define MK_REPEAT -1
#endif
#ifndef MK_DEBUG_STOP
#define MK_DEBUG_STOP 99
#endif
#ifndef MK_DEBUG_MODE
#define MK_DEBUG_MODE 100
#endif

constexpr size_t MiB = 1u << 20;
constexpr size_t WS_CTL = 0, CTL_ZERO_BYTES = 1 * MiB;
constexpr size_t WS_MODS = 1 * MiB;
constexpr size_t WS_WGU1 = 2 * MiB, WS_WGU2 = 13 * MiB, WS_WD1 = 24 * MiB, WS_WD2 = 30 * MiB, WS_WIN = 36 * MiB, WS_WOUT = 44 * MiB;
constexpr size_t WS_XN = 48 * MiB;
constexpr size_t WS_H = 112 * MiB;
constexpr size_t WS_QO = 112 * MiB, WS_KA = 176 * MiB, WS_VA = 208 * MiB, WS_QI = 240 * MiB, WS_KI = 272 * MiB, WS_WI = 276 * MiB, WS_MASK = 277 * MiB;
constexpr size_t WS_H1 = 288 * MiB;
constexpr size_t WS_F = 416 * MiB;
constexpr size_t WS_KB = 416 * MiB, WS_VB = 448 * MiB, WS_END = 480 * MiB;
static_assert(WS_H + (size_t)M * FF * 2 <= WS_H1 && WS_MASK + (size_t)M * 256 <= WS_H1 && WS_WOUT + (size_t)D * D * 2 <= WS_XN, "d_ws map");
constexpr int CW_TMO = 0, CW_BAR = 4096;

constexpr int RING_OFF = 0, RING_BYTES = 135168;
constexpr int LDSCTL_OFF = RING_BYTES, MISC_OFF = LDSCTL_OFF + 320;
constexpr int LDS_BYTES = 147456;

typedef GAS unsigned gu32;
#define RLX_AGENT __ATOMIC_RELAXED, __HIP_MEMORY_SCOPE_AGENT
#define LDS_WAIT() asm volatile("s_waitcnt lgkmcnt(0)" ::: "memory")
#define VM_WAIT() asm volatile("s_waitcnt vmcnt(0)" ::: "memory")

#define XB_TMO      128
#define XB_XCNT(j)  (256  + 64 * (j))
#define XB_XSUB(j)  (1280 + 64 * (j))
#define XB_XGEN(j)  (2304 + 64 * (j))
#define XB_TOP      3328
#define XB_TOPGEN   3392
#define XCD_BAR_WORDS 3456
#define XB_SPIN_CAP (1u << 18)
__device__ __forceinline__ unsigned xb_ld(unsigned* p)              { return __hip_atomic_load(p, __ATOMIC_RELAXED, __HIP_MEMORY_SCOPE_AGENT); }
__device__ __forceinline__ unsigned xb_add(unsigned* p, unsigned v) { return __hip_atomic_fetch_add(p, v, __ATOMIC_RELAXED, __HIP_MEMORY_SCOPE_AGENT); }
__device__ __forceinline__ unsigned xb_xcc_id() { return (unsigned)__builtin_amdgcn_s_getreg((3 << 11) | 20) & 0xFu; }
#define XB_SPIN(cond, bar) do { unsigned _sp = 0; while (cond) { __builtin_amdgcn_s_sleep(1); \
    if ((++_sp & 255u) == 0u) { if (xb_ld(&(bar)[XB_TMO])) break; if (_sp > XB_SPIN_CAP) { atomicAdd(&(bar)[XB_TMO], 1u); break; } } } } while (0)
struct XcdBarrier { unsigned* bar; unsigned x; volatile LAS unsigned* st; };
__device__ __forceinline__ XcdBarrier xcd_barrier_post(unsigned* bar, volatile LAS unsigned* st) {
    XcdBarrier b; b.bar = bar; b.x = xb_xcc_id(); b.st = st;
    if (threadIdx.x == 0) (void)xb_add(&bar[XB_XCNT(b.x)], 1u);
    return b;
}
__device__ __forceinline__ void xcd_barrier_complete(unsigned* bar, unsigned x, unsigned& nloc, unsigned& nx) {
    const unsigned G = gridDim.x * gridDim.y * gridDim.z;
    unsigned sum, cnt, mine, sp = 0u;
    for (;;) {
        sum = 0u; cnt = 0u; mine = 0u;
#pragma unroll
        for (unsigned j = 0; j < 16; ++j) { const unsigned c = xb_ld(&bar[XB_XCNT(j)]); sum += c; cnt += (c > 0u) ? 1u : 0u; mine = (j == x) ? c : mine; }
        if (sum == G) break;
        __builtin_amdgcn_s_sleep(1);
        if ((++sp & 255u) == 0u) { if (xb_ld(&bar[XB_TMO])) break; if (sp > XB_SPIN_CAP) { atomicAdd(&bar[XB_TMO], 1u); break; } }
    }
    nloc = mine > 0u ? mine : 1u; nx = cnt > 0u ? cnt : 1u;
}
__device__ __forceinline__ void xcd_barrier(const XcdBarrier& b) {
    asm volatile("s_waitcnt vmcnt(0)" ::: "memory");
    __syncthreads();
    if (threadIdx.x == 0) {
        unsigned* bar = b.bar;
        __builtin_amdgcn_s_waitcnt(0);
        unsigned nloc = b.st[0], nx = b.st[1];
        if (nloc == 0u) { xcd_barrier_complete(bar, b.x, nloc, nx); b.st[0] = nloc; b.st[1] = nx; }
        const unsigned old = xb_add(&bar[XB_XSUB(b.x)], 1u);
        const unsigned gen = old / nloc;
        if (old + 1u == (gen + 1u) * nloc) {
            __builtin_amdgcn_fence(__ATOMIC_RELEASE, "agent");
            asm volatile("s_waitcnt vmcnt(0)" ::: "memory");
            const unsigned og = xb_add(&bar[XB_TOP], 1u);
            const unsigned tg = og / nx;
            if (og + 1u == (tg + 1u) * nx) xb_add(&bar[XB_TOPGEN], 1u);
            else XB_SPIN(xb_ld(&bar[XB_TOPGEN]) == tg, bar);
            __builtin_amdgcn_fence(__ATOMIC_ACQUIRE, "agent");
            xb_add(&bar[XB_XGEN(b.x)], 1u);
            asm volatile("s_waitcnt vmcnt(0)" ::: "memory");
        } else {
            XB_SPIN(xb_ld(&bar[XB_XGEN(b.x)]) == gen, bar);
            __builtin_amdgcn_fence(__ATOMIC_ACQUIRE, "agent");
            asm volatile("s_waitcnt vmcnt(0)" ::: "memory");
        }
    }
    __syncthreads();
}

struct Frame {
    LAS unsigned char* lds;
    int tid, lane, wave, vcu, G;
    const float *x, *c, *w_ada, *b_ada, *g_pre, *g_post, *w_gate, *w_up, *w_down, *w_in, *g_kidx, *rel_bias, *g_out_a, *g_out_b, *w_out;
    float* out;
    unsigned char* ws;
    __device__ __forceinline__ float* mods() const { return (float*)(ws + WS_MODS); }
    __device__ __forceinline__ h16* Wgu(int l) const { return (h16*)(ws + (l ? WS_WGU2 : WS_WGU1)); }
    __device__ __forceinline__ h16* Wd(int l) const { return (h16*)(ws + (l ? WS_WD2 : WS_WD1)); }
    __device__ __forceinline__ h16* Win() const { return (h16*)(ws + WS_WIN); }
    __device__ __forceinline__ h16* Wout() const { return (h16*)(ws + WS_WOUT); }
    __device__ __forceinline__ h16* XN() const { return (h16*)(ws + WS_XN); }
    __device__ __forceinline__ h16* H() const { return (h16*)(ws + WS_H); }
    __device__ __forceinline__ h16* QO() const { return (h16*)(ws + WS_QO); }
    __device__ __forceinline__ h16* KA() const { return (h16*)(ws + WS_KA); }
    __device__ __forceinline__ h16* VA() const { return (h16*)(ws + WS_VA); }
    __device__ __forceinline__ h16* QI() const { return (h16*)(ws + WS_QI); }
    __device__ __forceinline__ h16* KI() const { return (h16*)(ws + WS_KI); }
    __device__ __forceinline__ h16* KB() const { return (h16*)(ws + WS_KB); }
    __device__ __forceinline__ h16* VB() const { return (h16*)(ws + WS_VB); }
    __device__ __forceinline__ float* WI() const { return (float*)(ws + WS_WI); }
    __device__ __forceinline__ h16* H1() const { return (h16*)(ws + WS_H1); }
    __device__ __forceinline__ h16* Fb() const { return (h16*)(ws + WS_F); }
    __device__ __forceinline__ unsigned long long* MASK() const { return (unsigned long long*)(ws + WS_MASK); }
};
__device__ __forceinline__ float wave_sum(float v) {
#pragma unroll
    for (int o = 1; o < 64; o <<= 1) v += __shfl_xor(v, o);
    return v;
}
#define WG_BAR() asm volatile("s_waitcnt vmcnt(0) lgkmcnt(0)\n\ts_barrier" ::: "memory")

__device__ __forceinline__ void adaln_unit(const Frame& F, int u) {
    LAS float* s = (LAS float*)(F.lds + RING_OFF);
    LAS float* red = s + 16 * 1024;
    for (int i = F.tid; i < 16 * 1024; i += NWAVES * 64) { const float cv = F.c[i]; s[i] = cv / (1.0f + __expf(-cv)); }
    WG_BAR();
    float acc[16];
#pragma unroll
    for (int b = 0; b < 16; ++b) acc[b] = 0.f;
    const float* wp = F.w_ada + (size_t)(128 * F.wave) * NMOD + 64 * u + F.lane;
    for (int k = 0; k < 128; k += 4) {
        const float w0 = wp[(size_t)(k + 0) * NMOD], w1 = wp[(size_t)(k + 1) * NMOD], w2 = wp[(size_t)(k + 2) * NMOD], w3 = wp[(size_t)(k + 3) * NMOD];
#pragma unroll
        for (int b = 0; b < 16; ++b) { const f32x4 sv = *(const LAS f32x4*)(s + b * 1024 + 128 * F.wave + k); acc[b] += (sv.x * w0 + sv.y * w1) + (sv.z * w2 + sv.w * w3); }
    }
#pragma unroll
    for (int b = 0; b < 16; ++b) red[(F.wave * 16 + b) * 64 + F.lane] = acc[b];
    WG_BAR();
    for (int i = F.tid; i < 16 * 64; i += NWAVES * 64) { const int b = i >> 6, l = i & 63; float t = F.b_ada[64 * u + l];
#pragma unroll
        for (int w = 0; w < 8; ++w) t += red[(w * 16 + b) * 64 + l];
        F.mods()[(size_t)b * NMOD + 64 * u + l] = t; }
    WG_BAR();
}
__device__ __forceinline__ void tr_item(const float* W, int ldw, int k0, int src_col0, int ncols, h16* WT, int dst_row0, int K, LAS float* scr, int lane) {
    const int cl = lane & 31;
#pragma unroll 8
    for (int i = 0; i < 32; ++i) { const int kk = 2 * i + (lane >> 5); scr[kk * 33 + cl] = (cl < ncols) ? W[(size_t)(k0 + kk) * ldw + src_col0 + cl] : 0.f; }
    LDS_WAIT(); asm volatile("" ::: "memory");
    const int c = lane & 7;
#pragma unroll
    for (int j = 0; j < 4; ++j) { const int n = (lane >> 3) + 8 * j; const LAS float* sp = scr + (8 * c) * 33 + n;
        u32x4 o; o.x = pkh(sp[0 * 33], sp[1 * 33]); o.y = pkh(sp[2 * 33], sp[3 * 33]); o.z = pkh(sp[4 * 33], sp[5 * 33]); o.w = pkh(sp[6 * 33], sp[7 * 33]);
        *(GAS u32x4*)(WT + (size_t)(dst_row0 + n) * K + k0 + 8 * c) = o; }
    LDS_WAIT(); asm volatile("" ::: "memory");
}
__device__ __forceinline__ void p0_prologue(const Frame& F) {
    if (F.vcu < 144) adaln_unit(F, F.vcu);
    LAS float* scr = (LAS float*)(F.lds + RING_OFF + F.wave * 16384);
    const int gw = F.vcu * NWAVES + F.wave, NGW = F.G * NWAVES;
    constexpr int I_GU = 16 * 176, I_DN = 44 * 32, I_IN = 16 * 120, I_OUT = 16 * 32, NITEMS = 2 * I_GU + 2 * I_DN + I_IN + I_OUT;
    for (int it = gw; it < NITEMS; it += NGW) {
        int r = it;
        if (r < 2 * I_GU) { const int l = r / I_GU; r -= l * I_GU; const int kb = r / 176, nb = r % 176, pn = nb >> 3, rr = (nb & 7) * 32;
            const float* src = (rr < 128 ? F.w_gate : F.w_up) + (size_t)l * D * FF;
            tr_item(src, FF, 64 * kb, 128 * pn + (rr & 127), 32, F.Wgu(l), 32 * nb, D, scr, F.lane); continue; }
        r -= 2 * I_GU;
        if (r < 2 * I_DN) { const int l = r / I_DN; r -= l * I_DN; const int kb = r / 32, nb = r % 32;
            tr_item(F.w_down + (size_t)l * FF * D, D, 64 * kb, 32 * nb, 32, F.Wd(l), 32 * nb, FF, scr, F.lane); continue; }
        r -= 2 * I_DN;
        if (r < I_IN) { const int kb = r / 120, nb = r % 120, pn = nb >> 3, sel = pn >> 1; int sc0, nc = 32;
            if (pn < 14) { const int base = (sel == 0) ? 0 : (sel == 1) ? 2120 : (sel == 2) ? 512 : (sel == 3) ? 1024 : (sel == 4) ? 1536 : (sel == 5) ? 2632 : 3144; sc0 = base + 32 * nb - 512 * sel; }
            else { const int gI = nb & 7; if (gI == 0) sc0 = 2048; else if (gI == 1) { sc0 = 2112; nc = 8; } else if (gI == 4) sc0 = 2080; else { sc0 = 0; nc = 0; } }
            tr_item(F.w_in, INCOLS, 64 * kb, sc0, nc, F.Win(), 32 * nb, D, scr, F.lane); continue; }
        r -= I_IN;
        { const int kb = r / 32, nb = r % 32; tr_item(F.w_out, D, 64 * kb, 32 * nb, 32, F.Wout(), 32 * nb, D, scr, F.lane); }
    }
}

__device__ __forceinline__ void prenorm_phase(const Frame& F, const float* src, int ns) {
    const int gw = F.vcu * NWAVES + F.wave, NGW = F.G * NWAVES;
    for (int r0 = gw * 16; r0 < M; r0 += NGW * 16) {
        const int b = r0 / SEQ; const float* md = F.mods() + (size_t)b * NMOD;
        f32x4 a2[4], b2[4];
#pragma unroll
        for (int j = 0; j < 4; ++j) { const int col = 4 * F.lane + 256 * j; const f32x4 g = *(const f32x4*)(F.g_pre + ns * D + col), sc = *(const f32x4*)(md + (3 * ns + 1) * D + col);
            a2[j] = g * (1.0f + sc); b2[j] = *(const f32x4*)(md + (3 * ns) * D + col); }
        for (int r = r0; r < r0 + 16; ++r) {
            const GAS f32x4* xr = (const GAS f32x4*)(src + (size_t)r * D) + F.lane; f32x4 v[4]; float s = 0.f;
#pragma unroll
            for (int j = 0; j < 4; ++j) { v[j] = xr[64 * j]; s += (v[j].x * v[j].x + v[j].y * v[j].y) + (v[j].z * v[j].z + v[j].w * v[j].w); }
            const float rstd = 1.0f / sqrtf(wave_sum(s) * (1.0f / D) + EPS);
            GAS u32x2* o8 = (GAS u32x2*)(F.XN() + (size_t)r * D) + F.lane;
#pragma unroll
            for (int j = 0; j < 4; ++j) { const f32x4 n = v[j] * rstd * a2[j] + b2[j]; u32x2 w; w.x = pkh(n.x, n.y); w.y = pkh(n.z, n.w); o8[64 * j] = w; }
        }
    }
}
typedef _Float16 hf4 __attribute__((ext_vector_type(4)));
__device__ __forceinline__ f32x4 ld4h(const h16* p) { const hf4 v = *(const GAS hf4*)p; return __builtin_convertvector(v, f32x4); }
template <bool BASE32, bool OUT32>
__device__ __forceinline__ void resnorm_phase(const Frame& F, int sub, float gmul, int ns) {
    const int gw = F.vcu * NWAVES + F.wave, NGW = F.G * NWAVES;
    for (int r0 = gw * 16; r0 < M; r0 += NGW * 16) {
        const int b = r0 / SEQ; const float* md = F.mods() + (size_t)b * NMOD;
        f32x4 c1[4], a2[4], b2[4];
#pragma unroll
        for (int j = 0; j < 4; ++j) { const int col = 4 * F.lane + 256 * j;
            c1[j] = *(const f32x4*)(md + (3 * sub + 2) * D + col) * *(const f32x4*)(F.g_post + sub * D + col) * gmul;
            if (ns >= 0) { const f32x4 g = *(const f32x4*)(F.g_pre + ns * D + col), sc = *(const f32x4*)(md + (3 * ns + 1) * D + col); a2[j] = g * (1.0f + sc); b2[j] = *(const f32x4*)(md + (3 * ns) * D + col); }
            else { a2[j] = (f32x4){0.f, 0.f, 0.f, 0.f}; b2[j] = a2[j]; } }
        for (int r = r0; r < r0 + 16; ++r) {
            const size_t ro = (size_t)r * D + 4 * F.lane;
            f32x4 f[4], h[4]; float s = 0.f;
#pragma unroll
            for (int j = 0; j < 4; ++j) { f[j] = ld4h(F.Fb() + ro + 256 * j); h[j] = BASE32 ? *(const GAS f32x4*)(F.x + ro + 256 * j) : ld4h(F.H1() + ro + 256 * j);
                s += (f[j].x * f[j].x + f[j].y * f[j].y) + (f[j].z * f[j].z + f[j].w * f[j].w); }
            const float rstd = 1.0f / sqrtf(wave_sum(s) * (1.0f / D) + EPS);
            float s2 = 0.f;
#pragma unroll
            for (int j = 0; j < 4; ++j) { h[j] = h[j] + c1[j] * f[j] * rstd;
                if (OUT32) *(GAS f32x4*)(F.out + ro + 256 * j) = h[j]; else { u32x2 w; w.x = pkh(h[j].x, h[j].y); w.y = pkh(h[j].z, h[j].w); *(GAS u32x2*)(F.H1() + ro + 256 * j) = w; }
                s2 += (h[j].x * h[j].x + h[j].y * h[j].y) + (h[j].z * h[j].z + h[j].w * h[j].w); }
            if (ns >= 0) {
                const float r2 = 1.0f / sqrtf(wave_sum(s2) * (1.0f / D) + EPS);
#pragma unroll
                for (int j = 0; j < 4; ++j) { const f32x4 n = h[j] * r2 * a2[j] + b2[j]; u32x2 w; w.x = pkh(n.x, n.y); w.y = pkh(n.z, n.w); *(GAS u32x2*)(F.XN() + ro + 256 * j) = w; }
            }
        }
    }
}
__device__ __forceinline__ void onorm_phase(const Frame& F) {
    const int gw = F.vcu * NWAVES + F.wave, NGW = F.G * NWAVES;
    f32x4 ga[2][2];
#pragma unroll
    for (int j = 0; j < 2; ++j)
#pragma unroll
        for (int e = 0; e < 2; ++e) ga[j][e] = *(const f32x4*)((j == 0 ? F.g_out_a : F.g_out_b) + 8 * F.lane + 4 * e);
    for (int r = gw; r < M; r += NGW) {
        GAS u32x4* p = (GAS u32x4*)(F.QO() + (size_t)r * D) + F.lane;
#pragma unroll
        for (int j = 0; j < 2; ++j) {
            const u32x4 raw = p[64 * j]; const hf8 hv = __builtin_bit_cast(hf8, raw); float v[8]; float s = 0.f;
#pragma unroll
            for (int e = 0; e < 8; ++e) { v[e] = (float)hv[e]; s += v[e] * v[e]; }
            const float rstd = 1.0f / sqrtf(wave_sum(s) * (1.0f / 512.0f) + EPS);
            u32x4 w; w.x = pkh(v[0] * rstd * ga[j][0][0], v[1] * rstd * ga[j][0][1]); w.y = pkh(v[2] * rstd * ga[j][0][2], v[3] * rstd * ga[j][0][3]);
            w.z = pkh(v[4] * rstd * ga[j][1][0], v[5] * rstd * ga[j][1][1]); w.w = pkh(v[6] * rstd * ga[j][1][2], v[7] * rstd * ga[j][1][3]);
            p[64 * j] = w;
        }
    }
}

constexpr int SC_LD = 2052;
__device__ __forceinline__ unsigned f2ord(float f) { const unsigned u = __builtin_bit_cast(unsigned, f); return (u & 0x80000000u) ? ~u : (u | 0x80000000u); }
__device__ __forceinline__ float ord2f(unsigned o) { const unsigned u = (o & 0x80000000u) ? (o & 0x7fffffffu) : ~o; return __builtin_bit_cast(float, u); }
__device__ __forceinline__ int wave_sum_i(int v) {
    v += __builtin_amdgcn_update_dpp(0, v, 0x111, 0xf, 0xf, true); v += __builtin_amdgcn_update_dpp(0, v, 0x112, 0xf, 0xf, true);
    v += __builtin_amdgcn_update_dpp(0, v, 0x114, 0xf, 0xf, true); v += __builtin_amdgcn_update_dpp(0, v, 0x118, 0xf, 0xf, true);
    v += __builtin_amdgcn_update_dpp(0, v, 0x142, 0xa, 0xf, false);
    v += __builtin_amdgcn_update_dpp(0, v, 0x143, 0xc, 0xf, false);
    return __builtin_amdgcn_readlane(v, 63);
}
__device__ __forceinline__ float wave_max_f(float x) {
    int v = __builtin_bit_cast(int, x);
#define WMX(ctrl, rm) do { const int t_ = __builtin_amdgcn_update_dpp(v, v, ctrl, rm, 0xf, false); v = __builtin_bit_cast(int, fmaxf(__builtin_bit_cast(float, v), __builtin_bit_cast(float, t_))); } while (0)
    WMX(0x111, 0xf); WMX(0x112, 0xf); WMX(0x114, 0xf); WMX(0x118, 0xf); WMX(0x142, 0xa); WMX(0x143, 0xc);
#undef WMX
    return __builtin_bit_cast(float, __builtin_amdgcn_readlane(v, 63));
}
__device__ __forceinline__ void idx_unit(const Frame& F, int b, int blk) {
    LAS float* sc = (LAS float*)(F.lds + RING_OFF);
    const int lane = F.lane, wid = F.wave, t0 = blk * 16; const size_t rowbase = (size_t)b * SEQ;
    {
        const h16* qp = F.QI() + (rowbase + t0 + (lane & 15)) * 512 + (lane >> 4) * 8;
        hf8 bq[8][2];
#pragma unroll
        for (int h = 0; h < 8; ++h)
#pragma unroll
            for (int ks = 0; ks < 2; ++ks) bq[h][ks] = __builtin_bit_cast(hf8, *(const u32x4*)(qp + h * 64 + ks * 32));
        const float* wp = F.WI() + (rowbase + t0 + (lane & 15)) * 8; const f32x4 wa = *(const f32x4*)wp, wb = *(const f32x4*)(wp + 4);
        const float w[8] = {wa.x, wa.y, wa.z, wa.w, wb.x, wb.y, wb.z, wb.w};
        const h16* kbase = F.KI() + (rowbase + (lane & 15)) * 64 + (lane >> 4) * 8;
        u32x4 r0 = {0u, 0u, 0u, 0u}, r1 = r0;
        if (wid <= blk) { r0 = *(const u32x4*)(kbase + (size_t)wid * 1024); r1 = *(const u32x4*)(kbase + (size_t)wid * 1024 + 32); }
        for (int kt = wid; kt <= blk; kt += NWAVES) {
            const hf8 a0 = __builtin_bit_cast(hf8, r0), a1 = __builtin_bit_cast(hf8, r1);
            if (kt + NWAVES <= blk) { r0 = *(const u32x4*)(kbase + (size_t)(kt + NWAVES) * 1024); r1 = *(const u32x4*)(kbase + (size_t)(kt + NWAVES) * 1024 + 32); }
            f32x4 acc = {0.f, 0.f, 0.f, 0.f};
#pragma unroll
            for (int h = 0; h < 8; ++h) { f32x4 d = __builtin_amdgcn_mfma_f32_16x16x32_f16(a0, bq[h][0], (f32x4){0.f, 0.f, 0.f, 0.f}, 0, 0, 0); d = __builtin_amdgcn_mfma_f32_16x16x32_f16(a1, bq[h][1], d, 0, 0, 0);
#pragma unroll
                for (int i = 0; i < 4; ++i) acc[i] += w[h] * fmaxf(d[i], 0.f); }
            *(LAS f32x4*)(sc + (lane & 15) * SC_LD + 16 * kt + 4 * (lane >> 4)) = acc;
        }
    }
    WG_BAR();
    for (int rr = 0; rr < 2; ++rr) {
        const int row = 2 * wid + rr, t = t0 + row; float v[32];
        const float NINF = -__builtin_inff();
        const int nch = (t >> 9) + 1;
#pragma unroll
        for (int j = 0; j < 32; ++j) { const int key = 64 * j + lane; const float x = sc[row * SC_LD + key]; v[j] = (key <= t) ? x : NINF; }
        float theta = NINF; bool ties = false; int take = 0;
        if (t + 1 > 256) {
            float mx = v[0], mn = (lane <= t) ? -v[0] : NINF;
#pragma unroll
            for (int j = 1; j < 32; ++j) { mx = fmaxf(mx, v[j]); mn = fmaxf(mn, (64 * j + lane <= t) ? -v[j] : NINF); }
            float hi = wave_max_f(mx), lo = -wave_max_f(mn);
#define CGE8(x, c_, j0) _Pragma("unroll") for (int j = j0; j < j0 + 8; ++j) c_ += (v[j] >= (x)) ? 1 : 0
#define CGE(x, out) do { int c_ = 0; CGE8(x, c_, 0); if (nch > 1) { CGE8(x, c_, 8); } if (nch > 2) { CGE8(x, c_, 16); } if (nch > 3) { CGE8(x, c_, 24); } out = wave_sum_i(c_); } while (0)
            int chi; CGE(hi, chi);
            if (chi >= 256) { theta = hi; if (chi > 256) { ties = true; take = 256; } }
            else {
                for (int it = 0; ; ++it) {
                    float mid = lo + (hi - lo) * 0.5f;
                    if (it >= 24 || !(mid > lo && mid < hi)) { const unsigned ul = f2ord(lo), uh = f2ord(hi), um = ul + ((uh - ul) >> 1);
                        if (um == ul) { theta = lo; ties = true; take = 256 - chi; break; }
                        mid = ord2f(um); }
                    int c; CGE(mid, c);
                    if (c == 256) { theta = mid; break; }
                    if (c > 256) lo = mid; else { hi = mid; chi = c; }
                }
            }
#undef CGE
#undef CGE8
        }
        unsigned long long mine = 0ull;
        if (!ties) {
#pragma unroll
            for (int j = 0; j < 32; ++j) { const unsigned long long bj = __ballot(v[j] >= theta && (64 * j + lane <= t)); if (lane == j) mine = bj; }
        } else {
            int left = take;
#pragma unroll
            for (int j = 0; j < 32; ++j) { const unsigned long long gt = __ballot(v[j] > theta); unsigned long long eq = __ballot(v[j] == theta);
                int ne = __popcll(eq); while (ne > left) { eq &= ~(1ull << (63 - __builtin_clzll(eq))); --ne; }
                left -= ne; if (lane == j) mine = gt | eq; }
        }
        if (lane < 32) F.MASK()[(rowbase + t) * 32 + lane] = mine;
    }
    WG_BAR();
}

__device__ __forceinline__ void idx_naive_phase(const Frame& F) {
    LAS float* qs = (LAS float*)(F.lds + RING_OFF) + F.wave * 2560;
    LAS float* ss = qs + 512;
    const int gw = F.vcu * NWAVES + F.wave, NGW = F.G * NWAVES, lane = F.lane;
    for (int row = gw; row < M; row += NGW) {
        const int b = row / SEQ, t = row % SEQ; const size_t rowbase = (size_t)b * SEQ;
        for (int i = lane; i < 512; i += 64) { const _Float16 hv = __builtin_bit_cast(_Float16, F.QI()[(size_t)row * 512 + i]); qs[i] = (float)hv; }
        float w[8];
#pragma unroll
        for (int h = 0; h < 8; ++h) w[h] = F.WI()[(size_t)row * 8 + h];
        LDS_WAIT();
        for (int j = 0; j < 32; ++j) { const int key = 64 * j + lane; float sc = -__builtin_inff();
            if (key <= t) { const h16* kp = F.KI() + (rowbase + key) * 64; float d[8];
#pragma unroll
                for (int h = 0; h < 8; ++h) d[h] = 0.f;
#pragma unroll
                for (int c = 0; c < 8; ++c) { const hf8 v = __builtin_bit_cast(hf8, *(const u32x4*)(kp + 8 * c));
#pragma unroll
                    for (int h = 0; h < 8; ++h)
#pragma unroll
                        for (int e = 0; e < 8; ++e) d[h] += qs[h * 64 + 8 * c + e] * (float)v[e]; }
                sc = 0.f;
#pragma unroll
                for (int h = 0; h < 8; ++h) sc += w[h] * fmaxf(d[h], 0.f); }
            ss[key] = sc; }
        LDS_WAIT();
        unsigned long long mine = 0ull;
        for (int j = 0; j < 32; ++j) { const int key = 64 * j + lane; const float me = ss[key]; int rank = 0;
            for (int k2 = 0; k2 <= t; ++k2) { const float o = ss[k2]; rank += (o > me || (o == me && k2 < key)) ? 1 : 0; }
            const unsigned long long bj = __ballot(key <= t && rank < 256); if (lane == j) mine = bj; }
        if (lane < 32) F.MASK()[(size_t)row * 32 + lane] = mine;
        LDS_WAIT();
    }
}
__device__ __forceinline__ void idx_phase(const Frame& F) {
    for (int i = 0; ; ++i) { const int u = i * F.G + F.vcu; if (u >= NB * 128) break;
        const int rnd = u >> 8, c = u & 255, b = c >> 4, s = c & 15, blk = (rnd & 1) ? 16 * rnd + 15 - s : 16 * rnd + s;
        idx_unit(F, b, blk); }
}

namespace att {
constexpr int SLOTB = 8192, L_K = 0, L_V = 2 * SLOTB, L_WS = 4 * SLOTB, L_OST = L_WS + NWAVES * 64 * 4, L_TBL = L_OST + NWAVES * 4096, L_FLAG = L_TBL + 384 * 4, L_END = L_FLAG + 16;
static_assert(L_END <= RING_BYTES, "attention LDS map");
__device__ __forceinline__ int crow(int r, int hi) { return (r & 3) + 8 * (r >> 2) + 4 * hi; }
__device__ __forceinline__ void glds16(const void* gsrc, unsigned lds_dst) { unsigned keep;
    asm volatile("s_mov_b32 %0, m0\n\ts_mov_b32 m0, %2\n\ts_nop 0\n\tglobal_load_lds_dwordx4 %1, off\n\ts_mov_b32 m0, %0" : "=&s"(keep) : "v"(gsrc), "s"(lds_dst) : "memory"); }
#define ATT_WAIT_BAR(N) asm volatile("s_waitcnt vmcnt(" #N ") lgkmcnt(0)\n\ts_barrier" ::: "memory")
__device__ __forceinline__ void qkt(f32x16& p0, f32x16& p1, const LAS unsigned char* Kslot, const hf8* qr, const f32x16& ci, int r32, int hi) {
    const LAS unsigned char* kb = Kslot + hi * 1024 + r32 * 16;
#pragma unroll
    for (int d0 = 0; d0 < 4; ++d0) {
        const hf8 b0 = *(const LAS hf8*)(kb + d0 * 2048), b1 = *(const LAS hf8*)(kb + d0 * 2048 + 512);
        if (d0 == 0) { p0 = __builtin_amdgcn_mfma_f32_32x32x16_f16(b0, qr[0], ci, 0, 0, 0); p1 = __builtin_amdgcn_mfma_f32_32x32x16_f16(b1, qr[0], ci, 0, 0, 0); }
        else { p0 = __builtin_amdgcn_mfma_f32_32x32x16_f16(b0, qr[d0], p0, 0, 0, 0); p1 = __builtin_amdgcn_mfma_f32_32x32x16_f16(b1, qr[d0], p1, 0, 0, 0); } }
}
__device__ __forceinline__ s16x4 vtr(const LAS unsigned char* p) { return __builtin_bit_cast(s16x4, __builtin_amdgcn_ds_read_tr16_b64_v4i16((LAS v4i16_t*)p)); }
__device__ __forceinline__ void pv(f32x16* o, const LAS unsigned char* vp, const hf8 (&pa)[4]) {
#pragma unroll
    for (int d0 = 0; d0 < 2; ++d0)
#pragma unroll
        for (int ks = 0; ks < 4; ++ks) { const s16x4 lo = vtr(vp + d0 * 4096 + ks * 1024), hi = vtr(vp + d0 * 4096 + ks * 1024 + 512);
            const hf8 vf = __builtin_bit_cast(hf8, (short __attribute__((ext_vector_type(8)))){lo[0], lo[1], lo[2], lo[3], hi[0], hi[1], hi[2], hi[3]});
            o[d0] = __builtin_amdgcn_mfma_f32_32x32x16_f16(pa[ks], vf, o[d0], 0, 0, 0); }
}
__device__ __forceinline__ void half_pair(float v, float& lo, float& hi) { lo = v; hi = v; asm volatile("s_nop 1\n\tv_permlane32_swap_b32 %0, %1" : "+v"(lo), "+v"(hi)); }
__device__ __forceinline__ float half_swap_max(float m) { float a, b; half_pair(m, a, b); return fmaxf(a, b); }
__device__ __forceinline__ float half_swap_sum(float m) { float a, b; half_pair(m, a, b); return a + b; }
__device__ __forceinline__ void pack4(hf8 (&pa)[4], const f32x16& p0, const f32x16& p1) {
#pragma unroll
    for (int ks = 0; ks < 4; ++ks) { const f32x16& p = (ks < 2) ? p0 : p1; const int o = (ks & 1) * 8;
        u32x4 w; w.x = pkh(p[o + 0], p[o + 1]); w.y = pkh(p[o + 2], p[o + 3]); w.z = pkh(p[o + 4], p[o + 5]); w.w = pkh(p[o + 6], p[o + 7]); pa[ks] = __builtin_bit_cast(hf8, w); }
}
__device__ __forceinline__ void store_o(const f32x16* o, const float* sc, h16* Ow, int pitch, LAS unsigned char* lds, int wid, int lane, int r32, int hi) {
    LAS h16* stg = (LAS h16*)(lds + L_OST) + wid * 2048;
#pragma unroll
    for (int r = 0; r < 16; ++r) { const int orow = crow(r, hi);
#pragma unroll
        for (int d0 = 0; d0 < 2; ++d0) { const _Float16 hv = (_Float16)(o[d0][r] * sc[r]); stg[orow * 64 + d0 * 32 + r32] = __builtin_bit_cast(h16, hv); } }
    LDS_WAIT();
#pragma unroll
    for (int i = 0; i < 4; ++i) { const int row = i * 8 + (lane >> 3), ch = lane & 7; const u32x4 v = *(const LAS u32x4*)(stg + row * 64 + ch * 8); *(u32x4*)(Ow + (size_t)row * pitch + ch * 8) = v; }
}
__device__ __forceinline__ int t5_bucket(int n) {
    if (n < 16) return n;
    const int large = 16 + (int)(__log2f((float)n * (1.0f / 16.0f)) * (16.0f / 3.0f));
    return large < 31 ? large : 31;
}

__device__ __forceinline__ void dsa_unit(const Frame& F, int b, int h, int qb) {
    LAS unsigned char* lds = F.lds + RING_OFF;
    const int tid = F.tid, lane = F.lane, r32 = lane & 31, hi = lane >> 5, wid = F.wave;
    const int q0 = qb * 256; const size_t rowbase = (size_t)b * SEQ;
    const h16* Qw = F.QO() + (rowbase + q0 + wid * 32) * 1024 + h * 64;
    const h16* Kh = F.KA() + rowbase * 512 + h * 64; const h16* Vh = F.VA() + rowbase * 512 + h * 64;
    const unsigned lds0 = (unsigned)(uintptr_t)lds;
    LAS float* wsf = (LAS float*)(lds + L_WS) + wid * 64; LAS float* tbl = (LAS float*)(lds + L_TBL);
    const h16* ksrc = Kh + (size_t)lane * 512 + wid * 8;
    const h16* vsrc = Vh + (size_t)(16 * (wid & 3) + (lane >> 2)) * 512 + (wid >> 2) * 32 + (lane & 3) * 8;
    const unsigned kdst = lds0 + L_K + wid * 1024, vdst = lds0 + L_V + wid * 1024;
#define DMA_KV(t, slot) do { glds16(ksrc + (size_t)(t) * 64 * 512, (unsigned)__builtin_amdgcn_readfirstlane(kdst + (slot))); glds16(vsrc + (size_t)(t) * 64 * 512, (unsigned)__builtin_amdgcn_readfirstlane(vdst + (slot))); } while (0)
    const LAS unsigned char* vp0 = lds + L_V + ((lane >> 4) & 1) * 32 + (lane & 3) * 8 + (4 * hi + ((lane & 15) >> 2)) * 64;
    const int NT = 4 * (qb + 1);
    for (int d = tid; d < 384; d += NWAVES * 64) tbl[d] = F.rel_bias[t5_bucket(d) * 8 + h] * LOG2E;
    const float bias31 = F.rel_bias[31 * 8 + h] * LOG2E;
    DMA_KV(0, 0);
    hf8 qr[4];
#pragma unroll
    for (int d0 = 0; d0 < 4; ++d0) qr[d0] = __builtin_bit_cast(hf8, *(const u32x4*)(Qw + (size_t)r32 * 1024 + d0 * 16 + hi * 8));
    const int tq = q0 + wid * 32 + r32, tqmax = q0 + wid * 32 + 31;
    const unsigned long long* mrow = F.MASK() + (rowbase + tq) * 32;
    float m = -1e30f, l = 0.f; f32x16 o[2]; o[0] = f32x16{}; o[1] = f32x16{};
    const float NINF = -__builtin_inff();
    for (int t = 0; t < NT; ++t) {
        const int slot = (t & 1) * SLOTB;
#ifdef MK_DSA_NOMASK
        const int nvalid_ = tq - 64 * t + 1; const unsigned long long mw = nvalid_ >= 64 ? ~0ull : (nvalid_ <= 0 ? 0ull : ((1ull << nvalid_) - 1ull)); (void)mrow;
#else
        const unsigned long long mw = mrow[t];
#endif
        if (t + 1 < NT) { DMA_KV(t + 1, SLOTB - slot); ATT_WAIT_BAR(2); } else { ATT_WAIT_BAR(0); }
        if (64 * t <= tqmax) {
            const bool band = (t >= NT - 6);
            f32x16 ci; const float c0 = band ? 0.f : bias31;
#pragma unroll
            for (int r = 0; r < 16; ++r) ci[r] = c0;
            f32x16 p0, p1; qkt(p0, p1, lds + L_K + slot, qr, ci, r32, hi);
            if (band) {
#pragma unroll
                for (int r = 0; r < 16; ++r) { const int d0 = tq - (64 * t + crow(r, hi)); const int d1 = d0 - 32; p0[r] += tbl[d0 > 0 ? d0 : 0]; p1[r] += tbl[d1 > 0 ? d1 : 0]; }
            }
            const unsigned wl = (unsigned)mw >> (4 * hi), wh = (unsigned)(mw >> 32) >> (4 * hi);
#pragma unroll
            for (int r = 0; r < 16; ++r) { const int cb = (r & 3) + 8 * (r >> 2); p0[r] = ((wl >> cb) & 1u) ? p0[r] : NINF; p1[r] = ((wh >> cb) & 1u) ? p1[r] : NINF; }
            float rm = fmaxf(p0[0], p1[0]);
#pragma unroll
            for (int r = 1; r < 16; ++r) rm = fmaxf(rm, fmaxf(p0[r], p1[r]));
            rm = half_swap_max(rm);
            if (__any(rm > m + 8.0f)) {
                const float mn = fmaxf(m, rm), f = __builtin_amdgcn_exp2f(m - mn); l *= f; m = mn;
                if (hi == 0) wsf[r32] = f;
                LDS_WAIT();
#pragma unroll
                for (int d_ = 0; d_ < 2; ++d_)
#pragma unroll
                    for (int r = 0; r < 16; ++r) o[d_][r] *= wsf[crow(r, hi)];
            }
            float s = 0.f;
#pragma unroll
            for (int r = 0; r < 16; ++r) { p0[r] = __builtin_amdgcn_exp2f(p0[r] - m); p1[r] = __builtin_amdgcn_exp2f(p1[r] - m); s += p0[r] + p1[r]; }
            l += s;
            hf8 pa[4]; pack4(pa, p0, p1);
            pv(o, vp0 + slot, pa);
        }
        ATT_WAIT_BAR(2);
    }
    l = half_swap_sum(l);
    if (hi == 0) wsf[32 + r32] = l;
    LDS_WAIT();
    float rli[16];
#pragma unroll
    for (int r = 0; r < 16; ++r) rli[r] = 1.0f / wsf[32 + crow(r, hi)];
    store_o(o, rli, const_cast<h16*>(Qw), 1024, lds, wid, lane, r32, hi);
    ATT_WAIT_BAR(0);
#undef DMA_KV
}

__device__ __forceinline__ void sb_unit(const Frame& F, int b, int h, int qb) {
    LAS unsigned char* lds = F.lds + RING_OFF;
    const int lane = F.lane, r32 = lane & 31, hi = lane >> 5, wid = F.wave;
    const int q0 = qb * 256; const size_t rowbase = (size_t)b * SEQ;
    const h16* Qw = F.QO() + (rowbase + q0 + wid * 32) * 1024 + 512 + h * 64;
    const h16* Kh = F.KB() + rowbase * 512 + h * 64; const h16* Vh = F.VB() + rowbase * 512 + h * 64;
    const unsigned lds0 = (unsigned)(uintptr_t)lds;
    LAS unsigned* flag = (LAS unsigned*)(lds + L_FLAG);
    const h16* ksrc = Kh + (size_t)lane * 512 + wid * 8;
    const h16* vsrc = Vh + (size_t)(16 * (wid & 3) + (lane >> 2)) * 512 + (wid >> 2) * 32 + (lane & 3) * 8;
    const unsigned kdst = lds0 + L_K + wid * 1024, vdst = lds0 + L_V + wid * 1024;
#define DMA_KV(t, slot) do { glds16(ksrc + (size_t)(t) * 64 * 512, (unsigned)__builtin_amdgcn_readfirstlane(kdst + (slot))); glds16(vsrc + (size_t)(t) * 64 * 512, (unsigned)__builtin_amdgcn_readfirstlane(vdst + (slot))); } while (0)
    const LAS unsigned char* vp0 = lds + L_V + ((lane >> 4) & 1) * 32 + (lane & 3) * 8 + (4 * hi + ((lane & 15) >> 2)) * 64;
    const int NT = 4 * (qb + 1);
    if (F.tid == 0) flag[0] = 0u;
    DMA_KV(NT - 1, 0);
    hf8 qr[4];
#pragma unroll
    for (int d0 = 0; d0 < 4; ++d0) qr[d0] = __builtin_bit_cast(hf8, *(const u32x4*)(Qw + (size_t)r32 * 1024 + d0 * 16 + hi * 8));
    const int tq = q0 + wid * 32 + r32, tqmax = q0 + wid * 32 + 31;
    float R = 0.f; f32x16 o[2]; o[0] = f32x16{}; o[1] = f32x16{};
    bool done = false; int it = 0;
    for (int t = NT - 1; t >= 0; --t, ++it) {
        const int slot = (it & 1) * SLOTB;
        if (t > 0) { DMA_KV(t - 1, SLOTB - slot); ATT_WAIT_BAR(2); } else { ATT_WAIT_BAR(0); }
        if (!done && 64 * t < tqmax) {
            f32x16 ci = f32x16{}; f32x16 p0, p1; qkt(p0, p1, lds + L_K + slot, qr, ci, r32, hi);
            f32x16 s0, s1;
#pragma unroll
            for (int r = 0; r < 16; ++r) { const int key = 64 * t + crow(r, hi);
                { const float z = p0[r]; const float tt = __builtin_amdgcn_logf(1.0f + __builtin_amdgcn_exp2f(-fabsf(z))); s0[r] = (key < tq) ? fmaxf(z, 0.f) + tt : 0.f; p0[r] = fminf(z, 0.f) - tt; }
                { const float z = p1[r]; const float tt = __builtin_amdgcn_logf(1.0f + __builtin_amdgcn_exp2f(-fabsf(z))); s1[r] = (key + 32 < tq) ? fmaxf(z, 0.f) + tt : 0.f; p1[r] = fminf(z, 0.f) - tt; } }
            float T[8], ex[8];
#pragma unroll
            for (int g = 0; g < 8; ++g) { const f32x16& s = (g < 4) ? s0 : s1; const int rb = 4 * (g & 3); const float gsum = (s[rb] + s[rb + 1]) + (s[rb + 2] + s[rb + 3]);
                float slo, shi; half_pair(gsum, slo, shi); T[g] = slo + shi; ex[g] = hi ? 0.f : shi; }
            float suf[8]; suf[7] = 0.f;
#pragma unroll
            for (int g = 6; g >= 0; --g) suf[g] = suf[g + 1] + T[g + 1];
            const float total = suf[0] + T[0];
#pragma unroll
            for (int g = 0; g < 8; ++g) { float run = R + suf[g] + ex[g];
#pragma unroll
                for (int i = 3; i >= 0; --i) { const int r = 4 * (g & 3) + i; const int key = 64 * t + ((g < 4) ? 0 : 32) + crow(r, hi);
                    if (g < 4) { const float lsig = p0[r]; p0[r] = (key < tq) ? __builtin_amdgcn_exp2f(lsig - run) : 0.f; run += s0[r]; }
                    else { const float lsig = p1[r]; p1[r] = (key < tq) ? __builtin_amdgcn_exp2f(lsig - run) : 0.f; run += s1[r]; } } }
            R += total;
            hf8 pa[4]; pack4(pa, p0, p1);
            pv(o, vp0 + slot, pa);
            if (__all(R > 160.0f)) { done = true; if (lane == 0) __hip_atomic_fetch_add(flag, 1u, __ATOMIC_RELAXED, __HIP_MEMORY_SCOPE_WORKGROUP); }
        }
        ATT_WAIT_BAR(2);
        if (flag[0] >= (unsigned)NWAVES) break;
    }
    asm volatile("s_waitcnt vmcnt(0)" ::: "memory");
    float one[16];
#pragma unroll
    for (int r = 0; r < 16; ++r) one[r] = 1.0f;
    store_o(o, one, const_cast<h16*>(Qw), 1024, lds, wid, lane, r32, hi);
    ATT_WAIT_BAR(0);
#undef DMA_KV
}

__device__ __forceinline__ void dsa_naive_phase(const Frame& F) {
    const int gt = (F.vcu * NWAVES + F.wave) * 64 + F.lane, NT_ = F.G * NWAVES * 64;
    for (int item = gt; item < M * 8; item += NT_) {
        const int h = item & 7, row = item >> 3, b = row / SEQ, t = row % SEQ; const size_t rowbase = (size_t)b * SEQ;
        float q[64], o[64];
        { const h16* qp = F.QO() + (size_t)row * 1024 + h * 64;
#pragma unroll
          for (int c = 0; c < 8; ++c) { const hf8 v = __builtin_bit_cast(hf8, *(const u32x4*)(qp + 8 * c));
#pragma unroll
              for (int e = 0; e < 8; ++e) { q[8 * c + e] = (float)v[e]; o[8 * c + e] = 0.f; } } }
        float m = -1e30f, l = 0.f;
        const unsigned long long* mrow = F.MASK() + (size_t)row * 32;
        for (int s = 0; s <= t; ++s) {
            if (!((mrow[s >> 6] >> (s & 63)) & 1ull)) continue;
            const h16* kp = F.KA() + (rowbase + s) * 512 + h * 64; const h16* vp = F.VA() + (rowbase + s) * 512 + h * 64;
            float dot = 0.f;
#pragma unroll
            for (int c = 0; c < 8; ++c) { const hf8 v = __builtin_bit_cast(hf8, *(const u32x4*)(kp + 8 * c));
#pragma unroll
                for (int e = 0; e < 8; ++e) dot += q[8 * c + e] * (float)v[e]; }
            const float lg = dot + F.rel_bias[t5_bucket(t - s) * 8 + h] * LOG2E;
            if (lg > m) { const float f = __builtin_amdgcn_exp2f(m - lg); l *= f;
#pragma unroll
                for (int d = 0; d < 64; ++d) o[d] *= f;
                m = lg; }
            const float p = __builtin_amdgcn_exp2f(lg - m); l += p;
#pragma unroll
            for (int c = 0; c < 8; ++c) { const hf8 v = __builtin_bit_cast(hf8, *(const u32x4*)(vp + 8 * c));
#pragma unroll
                for (int e = 0; e < 8; ++e) o[8 * c + e] += p * (float)v[e]; }
        }
        const float il = 1.0f / l; h16* op = F.QO() + (size_t)row * 1024 + h * 64;
#pragma unroll
        for (int c = 0; c < 8; ++c) { u32x4 w; w.x = pkh(o[8 * c] * il, o[8 * c + 1] * il); w.y = pkh(o[8 * c + 2] * il, o[8 * c + 3] * il); w.z = pkh(o[8 * c + 4] * il, o[8 * c + 5] * il); w.w = pkh(o[8 * c + 6] * il, o[8 * c + 7] * il);
            *(u32x4*)(op + 8 * c) = w; }
    }
}

__device__ __forceinline__ void sb_naive_phase(const Frame& F) {
    const int gt = (F.vcu * NWAVES + F.wave) * 64 + F.lane, NT_ = F.G * NWAVES * 64;
    for (int item = gt; item < M * 8; item += NT_) {
        const int h = item & 7, row = item >> 3, b = row / SEQ, t = row % SEQ; const size_t rowbase = (size_t)b * SEQ;
        float q[64], o[64];
        { const h16* qp = F.QO() + (size_t)row * 1024 + 512 + h * 64;
#pragma unroll
          for (int c = 0; c < 8; ++c) { const hf8 v = __builtin_bit_cast(hf8, *(const u32x4*)(qp + 8 * c));
#pragma unroll
              for (int e = 0; e < 8; ++e) { q[8 * c + e] = (float)v[e]; o[8 * c + e] = 0.f; } } }
        float R = 0.f;
        for (int s = t - 1; s >= 0 && R < 120.f; --s) {
            const h16* kp = F.KB() + (rowbase + s) * 512 + h * 64; const h16* vp = F.VB() + (rowbase + s) * 512 + h * 64;
            float dot = 0.f;
#pragma unroll
            for (int c = 0; c < 8; ++c) { const hf8 v = __builtin_bit_cast(hf8, *(const u32x4*)(kp + 8 * c));
#pragma unroll
                for (int e = 0; e < 8; ++e) dot += q[8 * c + e] * (float)v[e]; }
            const float z = dot * (1.0f / LOG2E);
            const float sp = fmaxf(z, 0.f) + log1pf(expf(-fabsf(z)));
            const float a = expf((z - sp) - R);
            R += sp;
#pragma unroll
            for (int c = 0; c < 8; ++c) { const hf8 v = __builtin_bit_cast(hf8, *(const u32x4*)(vp + 8 * c));
#pragma unroll
                for (int e = 0; e < 8; ++e) o[8 * c + e] += a * (float)v[e]; }
        }
        h16* op = F.QO() + (size_t)row * 1024 + 512 + h * 64;
#pragma unroll
        for (int c = 0; c < 8; ++c) { u32x4 w; w.x = pkh(o[8 * c], o[8 * c + 1]); w.y = pkh(o[8 * c + 2], o[8 * c + 3]); w.z = pkh(o[8 * c + 4], o[8 * c + 5]); w.w = pkh(o[8 * c + 6], o[8 * c + 7]);
            *(u32x4*)(op + 8 * c) = w; }
    }
}
__device__ __forceinline__ void att_phase(const Frame& F) {
    for (int i = 0; ; ++i) { const int u = i * F.G + F.vcu; if (u >= 1024) break; const int rnd = u >> 8, c = u & 255, bh = c >> 1, sub = c & 1;
        const int qb = (rnd == 0) ? sub : (rnd == 1) ? 7 - sub : (rnd == 2) ? 2 + sub : 5 - sub;
#if !defined(MK_SKIP_DSA) && !defined(MK_NAIVE_DSA)
        dsa_unit(F, bh >> 3, bh & 7, qb);
#endif
    }
#ifdef MK_NAIVE_DSA
    dsa_naive_phase(F);
#endif
#ifdef MK_NAIVE_SB
    sb_naive_phase(F);
#endif
    for (int i = 0; ; ++i) { const int u = i * F.G + F.vcu; if (u >= 1024) break; const int rnd = u >> 8, c = u & 255, bh = c >> 1, sub = c & 1;
#if !defined(MK_SKIP_SB) && !defined(MK_NAIVE_SB)
        sb_unit(F, bh >> 3, bh & 7, 4 * sub + rnd);
#endif
    }
}
}

struct Args { const float* in[15]; float* out; unsigned char* ws; int ph_lo, ph_hi, li, pad; };
__global__ void __launch_bounds__(NWAVES * 64, 2) mk_fwd(Args args) {
    extern __shared__ __attribute__((aligned(16))) unsigned char lds_raw[];
    Frame F;
    F.lds = (LAS unsigned char*)lds_raw;
    volatile LAS unsigned* MISC = (volatile LAS unsigned*)(F.lds + MISC_OFF);
    F.tid = threadIdx.x; F.lane = F.tid & 63; F.wave = __builtin_amdgcn_readfirstlane(F.tid >> 6);
    F.G = gridDim.x; { const int bx = blockIdx.x; F.vcu = (F.G % 8 == 0) ? (bx % 8) * (F.G / 8) + bx / 8 : bx; }
    unsigned char* ws = args.ws;
    gu32* ctl = (gu32*)(ws + WS_CTL);
    F.x = args.in[0]; F.c = args.in[1]; F.w_ada = args.in[2]; F.b_ada = args.in[3]; F.g_pre = args.in[4]; F.g_post = args.in[5]; F.w_gate = args.in[6]; F.w_up = args.in[7]; F.w_down = args.in[8];
    F.w_in = args.in[9]; F.g_kidx = args.in[10]; F.rel_bias = args.in[11]; F.g_out_a = args.in[12]; F.g_out_b = args.in[13]; F.w_out = args.in[14]; F.out = args.out;
    F.ws = ws;
    for (int u = F.tid; u < (LDS_BYTES - LDSCTL_OFF) / 4; u += NWAVES * 64) ((LAS unsigned*)(F.lds + LDSCTL_OFF))[u] = 0u;
    __syncthreads();
    XcdBarrier bar; bar.bar = (unsigned*)(ctl + CW_BAR); bar.x = 0; bar.st = nullptr;
    if (N_LAUNCHES == 1) bar = xcd_barrier_post((unsigned*)(ctl + CW_BAR), MISC + 8);
#define GRID_BAR() do { if (N_LAUNCHES == 1) xcd_barrier(bar); } while (0)
    const int lo = args.ph_lo, hi = args.ph_hi;
#define IN(k) (lo <= (k) && (k) < hi)
#define SEAM(k) do { if (IN((k) + 1)) GRID_BAR(); } while (0)

    if (IN(0)) { for (int rep_ = 0; rep_ < (MK_REPEAT == 0 ? 2 : 1); ++rep_) { if (rep_) GRID_BAR(); p0_prologue(F); } SEAM(0); }
    if (IN(1)) { for (int rep_ = 0; rep_ < (MK_REPEAT == 1 ? 2 : 1); ++rep_) { if (rep_) GRID_BAR(); prenorm_phase(F, F.x, 0); } SEAM(1); }
    if (IN(2)) { _Pragma("unroll") for (int rep_ = 0; rep_ < (MK_REPEAT == 2 ? 2 : 1); ++rep_) { if (rep_) GRID_BAR(); pg8::Gemm g{F.XN(), F.Wgu(0), M, NGU, D}; pg8::StaticOrder S; S.init(M, NGU, F.G, (int)blockIdx.x); pg8::EpiSwiGLU E{F.H()};
        pg8::gemm_phase<pg8::EpiSwiGLU, pg8::StaticOrder>(F.lds + RING_OFF, g, S, E); } SEAM(2); }
    if (IN(3)) { _Pragma("unroll") for (int rep_ = 0; rep_ < (MK_REPEAT == 3 ? 2 : 1); ++rep_) { if (rep_) GRID_BAR(); pg8::Gemm g{F.H(), F.Wd(0), M, D, FF}; pg8::StaticOrder S; S.init(M, D, F.G, (int)blockIdx.x); pg8::EpiF16 E{F.Fb(), D};
        pg8::gemm_phase<pg8::EpiF16, pg8::StaticOrder>(F.lds + RING_OFF, g, S, E); } SEAM(3); }
    if (IN(4)) { for (int rep_ = 0; rep_ < (MK_REPEAT == 4 ? 2 : 1); ++rep_) { if (rep_) GRID_BAR(); resnorm_phase<true, false>(F, 0, 0.5f, 1); } SEAM(4); }
    if (IN(5)) { _Pragma("unroll") for (int rep_ = 0; rep_ < (MK_REPEAT == 5 ? 2 : 1); ++rep_) { if (rep_) GRID_BAR(); pg8::Gemm g{F.XN(), F.Win(), M, NINP, D}; pg8::StaticOrder S; S.init(M, NINP, F.G, (int)blockIdx.x); pg8::EpiInProj E{F.QO(), F.KA(), F.VA(), F.QI(), F.KB(), F.VB(), F.KI(), F.WI(), F.g_kidx};
        pg8::gemm_phase<pg8::EpiInProj, pg8::StaticOrder>(F.lds + RING_OFF, g, S, E); } SEAM(5); }
#ifdef MK_NAIVE_IDX
    if (IN(6)) { for (int rep_ = 0; rep_ < (MK_REPEAT == 6 ? 2 : 1); ++rep_) { if (rep_) GRID_BAR(); idx_naive_phase(F); } SEAM(6); }
#else
    if (IN(6)) { for (int rep_ = 0; rep_ < (MK_REPEAT == 6 ? 2 : 1); ++rep_) { if (rep_) GRID_BAR(); idx_phase(F); } SEAM(6); }
#endif
    if (IN(7)) { for (int rep_ = 0; rep_ < (MK_REPEAT == 7 ? 2 : 1); ++rep_) { if (rep_) GRID_BAR(); att::att_phase(F); } SEAM(7); }
    if (IN(8)) { for (int rep_ = 0; rep_ < (MK_REPEAT == 8 ? 2 : 1); ++rep_) { if (rep_) GRID_BAR(); onorm_phase(F); } SEAM(8); }
    if (IN(9)) { _Pragma("unroll") for (int rep_ = 0; rep_ < (MK_REPEAT == 9 ? 2 : 1); ++rep_) { if (rep_) GRID_BAR(); pg8::Gemm g{F.QO(), F.Wout(), M, D, D}; pg8::StaticOrder S; S.init(M, D, F.G, (int)blockIdx.x); pg8::EpiF16 E{F.Fb(), D};
        pg8::gemm_phase<pg8::EpiF16, pg8::StaticOrder>(F.lds + RING_OFF, g, S, E); } SEAM(9); }
    if (IN(10)) { for (int rep_ = 0; rep_ < (MK_REPEAT == 10 ? 2 : 1); ++rep_) { if (rep_) GRID_BAR(); resnorm_phase<false, false>(F, 1, 1.0f, 2); } SEAM(10); }
    if (IN(11)) { _Pragma("unroll") for (int rep_ = 0; rep_ < (MK_REPEAT == 11 ? 2 : 1); ++rep_) { if (rep_) GRID_BAR(); pg8::Gemm g{F.XN(), F.Wgu(1), M, NGU, D}; pg8::StaticOrder S; S.init(M, NGU, F.G, (int)blockIdx.x); pg8::EpiSwiGLU E{F.H()};
        pg8::gemm_phase<pg8::EpiSwiGLU, pg8::StaticOrder>(F.lds + RING_OFF, g, S, E); } SEAM(11); }
    if (IN(12)) { _Pragma("unroll") for (int rep_ = 0; rep_ < (MK_REPEAT == 12 ? 2 : 1); ++rep_) { if (rep_) GRID_BAR(); pg8::Gemm g{F.H(), F.Wd(1), M, D, FF}; pg8::StaticOrder S; S.init(M, D, F.G, (int)blockIdx.x); pg8::EpiF16 E{F.Fb(), D};
        pg8::gemm_phase<pg8::EpiF16, pg8::StaticOrder>(F.lds + RING_OFF, g, S, E); } SEAM(12); }
    if (IN(13)) { resnorm_phase<false, true>(F, 2, 0.5f, -1); }
#undef IN
#undef SEAM
#undef GRID_BAR
}

extern "C" void kernel_launch(void* const* d_in, const int* in_sizes, int n_in, void* d_out, int out_size, void* d_ws, size_t ws_size, hipStream_t stream) {
    static int grid = 0;
    if (grid == 0) {
        if (n_in != 15 || in_sizes[0] != M * D || out_size != M * D || ws_size < WS_END) { fprintf(stderr, "kernel_launch: unexpected shapes (n_in %d, in0 %d, out %d, ws %zu); nothing launched\n", n_in, n_in > 0 ? in_sizes[0] : -1, out_size, ws_size); grid = -1; return; }
        int dev = 0, cus = 0, per_cu = 0;
        if (hipGetDevice(&dev) != hipSuccess || hipDeviceGetAttribute(&cus, hipDeviceAttributeMultiprocessorCount, dev) != hipSuccess) { grid = -1; return; }
        if (hipFuncSetAttribute((const void*)mk_fwd, hipFuncAttributeMaxDynamicSharedMemorySize, LDS_BYTES) != hipSuccess) { fprintf(stderr, "kernel_launch: hipFuncSetAttribute failed\n"); grid = -1; return; }
        if (hipOccupancyMaxActiveBlocksPerMultiprocessor(&per_cu, (const void*)mk_fwd, NWAVES * 64, LDS_BYTES) != hipSuccess || per_cu < 1) fprintf(stderr, "kernel_launch: occupancy query reports %d\n", per_cu);
        (void)hipGetLastError();
        grid = cus;
    }
    if (grid < 0) return;
    if (hipMemsetAsync((char*)d_ws + WS_CTL, 0, CTL_ZERO_BYTES, stream) != hipSuccess) return;
    Args a{};
    for (int i = 0; i < 15; ++i) a.in[i] = (const float*)d_in[i];
    a.out = (float*)d_out; a.ws = (unsigned char*)d_ws;
    for (int li = 0; li < N_LAUNCHES; ++li) {
        a.ph_lo = (N_LAUNCHES == 1) ? 0 : li; a.ph_hi = (N_LAUNCHES == 1) ? NPHASE : li + 1; a.li = li;
        if (li > MK_DEBUG_STOP) { a.ph_lo = MK_DEBUG_MODE; a.ph_hi = MK_DEBUG_MODE + 1; }
        hipLaunchKernelGGL(mk_fwd, dim3(grid), dim3(NWAVES * 64), LDS_BYTES, stream, a);
        if (li > MK_DEBUG_STOP) break;
    }
}
```

```cpp
#include <hip/hip_runtime.h>
#include <cstdio>
#include <cstdint>
#include <cmath>

#define LAS __attribute__((address_space(3)))
#define GAS __attribute__((address_space(1)))
typedef unsigned short h16;
typedef _Float16 hf8 __attribute__((ext_vector_type(8)));
typedef _Float16 hf2 __attribute__((ext_vector_type(2)));
typedef float f32x2 __attribute__((ext_vector_type(2)));
typedef float f32x4 __attribute__((ext_vector_type(4)));
typedef float f32x16 __attribute__((ext_vector_type(16)));
typedef unsigned u32x2 __attribute__((ext_vector_type(2)));
typedef unsigned u32x4 __attribute__((ext_vector_type(4)));
typedef short s16x4 __attribute__((ext_vector_type(4)));
typedef short v4i16_t __attribute__((ext_vector_type(4)));

__device__ __forceinline__ unsigned pkh(float lo, float hi) { f32x2 v = {lo, hi}; hf2 h = __builtin_convertvector(v, hf2); return __builtin_bit_cast(unsigned, h); }

constexpr int NB = 16, SEQ = 2048, M = NB * SEQ, D = 1024, FF = 2816, NGU = 2 * FF, NINP = 3840, INCOLS = 3656, NMOD = 9 * D;
constexpr float EPS = 1e-6f;
constexpr float LOG2E = 1.4426950408889634f;
constexpr float C2 = 0.125f * LOG2E;

namespace pg8 {
constexpr int BM = 256, BK = 64, HALF = 128, HTB = HALF * BK * 2, STAGE_BYTES = 8 * HTB, NXCD = 8, WGM = 8;
__host__ __device__ __forceinline__ int lds_byte(int r, int c) { const int st = (r >> 4) * 2 + (c >> 5), rr = r & 15, cc = c & 31, ob = rr * 64 + cc * 2; return st * 1024 + (ob ^ (((ob >> 9) & 1) << 5)); }
__host__ __device__ __forceinline__ void stage_rc(int b, int& R, int& C) { const int st = b / 1024, sb = b % 1024, swz = sb ^ (((sb >> 9) & 1) << 5); R = (st >> 1) * 16 + swz / 64; C = (st & 1) * 32 + (swz % 64) / 2; }
__host__ __device__ __forceinline__ int perm32(int rho) { const int n = rho >> 4, i = rho & 15; return 8 * (i >> 2) + 4 * n + (i & 3); }
struct Unit { int pm, pn, par; };
struct Gemm { const h16* A; const h16* Bt; int M, N, K; };
struct StaticOrder {
    int nM, nN, nwg, G, c;
    __host__ __device__ void init(int M_, int N_, int G_, int c_) { nM = M_ / BM; nN = N_ / BM; nwg = nM * nN; G = G_; c = c_; }
    __host__ __device__ bool next(int i, Unit& u) const {
        const long L = (long)i * G + c; if (L >= nwg) return false;
        int wgid = (int)L; { const int q = nwg / NXCD, r = nwg % NXCD, xcd = wgid % NXCD, off = wgid / NXCD; wgid = (xcd < r ? xcd * (q + 1) : r * (q + 1) + (xcd - r) * q) + off; }
        const int nig = WGM * nN, gid = wgid / nig, fm = gid * WGM, gsz = (nM - fm) < WGM ? (nM - fm) : WGM;
        u.pm = fm + ((wgid % nig) % gsz); u.pn = (wgid % nig) / gsz; u.par = i & 1; return true;
    }
    __device__ __forceinline__ void a_ready(const Unit&) const {}
    __device__ __forceinline__ void done(const Unit&) const {}
};
__device__ __forceinline__ float silu_mul(float g, float u) { const float e = __builtin_amdgcn_exp2f(-g * LOG2E); return g * u * __builtin_amdgcn_rcpf(1.0f + e); }
struct EpiSwiGLU {
    static constexpr bool HAS_MID = false;
    static constexpr bool PERM = true;
    h16* H;
    __device__ __forceinline__ void operator()(const f32x4 (&acc)[2][2][4][2], const Unit& u, int wr, int wc, int fr, int fq) const {
        const int row0 = u.pm * BM + wr * 64 + fr, col0 = u.pn * HALF + wc * 32 + 8 * fq;
#pragma unroll
        for (int ai = 0; ai < 2; ++ai)
#pragma unroll
            for (int m = 0; m < 4; ++m) {
                const f32x4 g0 = acc[ai][0][m][0], g1 = acc[ai][0][m][1], u0 = acc[ai][1][m][0], u1 = acc[ai][1][m][1];
                u32x4 w; w.x = pkh(silu_mul(g0[0], u0[0]), silu_mul(g0[1], u0[1])); w.y = pkh(silu_mul(g0[2], u0[2]), silu_mul(g0[3], u0[3]));
                w.z = pkh(silu_mul(g1[0], u1[0]), silu_mul(g1[1], u1[1])); w.w = pkh(silu_mul(g1[2], u1[2]), silu_mul(g1[3], u1[3]));
                *(u32x4*)(H + (size_t)(row0 + ai * HALF + m * 16) * FF + col0) = w; }
    }
};
struct EpiF32 {
    static constexpr bool HAS_MID = false;
    static constexpr bool PERM = false;
    float* O; int ldc;
    __device__ __forceinline__ void operator()(const f32x4 (&acc)[2][2][4][2], const Unit& u, int wr, int wc, int fr, int fq) const {
        const int row0 = u.pm * BM + wr * 64 + fr, col0 = u.pn * BM + wc * 32 + 4 * fq;
#pragma unroll
        for (int ai = 0; ai < 2; ++ai)
#pragma unroll
            for (int m = 0; m < 4; ++m) { float* rowp = O + (size_t)(row0 + ai * HALF + m * 16) * ldc + col0;
#pragma unroll
                for (int bj = 0; bj < 2; ++bj)
#pragma unroll
                    for (int n = 0; n < 2; ++n) *(f32x4*)(rowp + bj * HALF + n * 16) = acc[ai][bj][m][n]; }
    }
};
struct EpiF16 {
    static constexpr bool HAS_MID = false;
    static constexpr bool PERM = true;
    h16* O; int ldc;
    __device__ __forceinline__ void operator()(const f32x4 (&acc)[2][2][4][2], const Unit& u, int wr, int wc, int fr, int fq) const {
        const int row0 = u.pm * BM + wr * 64 + fr, col0 = u.pn * BM + wc * 32 + 8 * fq;
#pragma unroll
        for (int ai = 0; ai < 2; ++ai)
#pragma unroll
            for (int m = 0; m < 4; ++m) { h16* rowp = O + (size_t)(row0 + ai * HALF + m * 16) * ldc + col0;
#pragma unroll
                for (int bj = 0; bj < 2; ++bj) { const f32x4 v0 = acc[ai][bj][m][0], v1 = acc[ai][bj][m][1];
                    u32x4 w; w.x = pkh(v0[0], v0[1]); w.y = pkh(v0[2], v0[3]); w.z = pkh(v1[0], v1[1]); w.w = pkh(v1[2], v1[3]);
                    *(u32x4*)(rowp + bj * HALF) = w; } }
    }
};
constexpr int TAB_OFF = STAGE_BYTES;
struct EpiOutProj {
    static constexpr bool PERM = true, HAS_MID = true;
    h16* O; const float* SS;
    __device__ __forceinline__ void begin(const Unit& u, LAS unsigned char* lds, int tid) const {
        if (tid < 256) { const f32x4* p = (const f32x4*)(SS + (size_t)(u.pm * BM + tid) * 16); const f32x4 a0 = p[0], a1 = p[1], b0 = p[2], b1 = p[3];
            const float sa = ((a0[0] + a0[1]) + (a0[2] + a0[3])) + ((a1[0] + a1[1]) + (a1[2] + a1[3])), sb = ((b0[0] + b0[1]) + (b0[2] + b0[3])) + ((b1[0] + b1[1]) + (b1[2] + b1[3]));
            const float ra = 1.0f / sqrtf(sa * (1.0f / 512.0f) + EPS), rb = 1.0f / sqrtf(sb * (1.0f / 512.0f) + EPS);
            *(LAS f32x2*)(lds + TAB_OFF + u.par * 2048 + tid * 8) = (f32x2){ra / rb, rb}; }
    }
    __device__ __forceinline__ void mid(f32x4 (&acc)[2][2][4][2], const Unit& u, LAS unsigned char* lds, int wr, int fr) const {
        const LAS unsigned char* tb = lds + TAB_OFF + u.par * 2048 + (wr * 64 + fr) * 8;
#pragma unroll
        for (int ai = 0; ai < 2; ++ai)
#pragma unroll
            for (int m = 0; m < 4; ++m) { const float s = *(const LAS float*)(tb + (ai * HALF + m * 16) * 8);
#pragma unroll
                for (int bj = 0; bj < 2; ++bj)
#pragma unroll
                    for (int n = 0; n < 2; ++n) acc[ai][bj][m][n] *= s; }
    }
    __device__ __forceinline__ void fin(const f32x4 (&acc)[2][2][4][2], const Unit& u, LAS unsigned char* lds, int wr, int wc, int fr, int fq) const {
        const int row0 = u.pm * BM + wr * 64 + fr, col0 = u.pn * BM + wc * 32 + 8 * fq; const LAS unsigned char* tb = lds + TAB_OFF + u.par * 2048 + (wr * 64 + fr) * 8 + 4;
#pragma unroll
        for (int ai = 0; ai < 2; ++ai)
#pragma unroll
            for (int m = 0; m < 4; ++m) { const float rb = *(const LAS float*)(tb + (ai * HALF + m * 16) * 8); h16* rowp = O + (size_t)(row0 + ai * HALF + m * 16) * D + col0;
#pragma unroll
                for (int bj = 0; bj < 2; ++bj) { const f32x4 v0 = acc[ai][bj][m][0] * rb, v1 = acc[ai][bj][m][1] * rb;
                    u32x4 w; w.x = pkh(v0[0], v0[1]); w.y = pkh(v0[2], v0[3]); w.z = pkh(v1[0], v1[1]); w.w = pkh(v1[2], v1[3]);
                    *(u32x4*)(rowp + bj * HALF) = w; } }
    }
    __device__ __forceinline__ void operator()(const f32x4 (&)[2][2][4][2], const Unit&, int, int, int, int) const {}
};
struct EpiInProj {
    static constexpr bool HAS_MID = false;
    static constexpr bool PERM = true;
    h16 *QO, *KA, *VA, *QI, *KB, *VB, *KI; float* WI; const float* gk;
    __device__ __forceinline__ void operator()(const f32x4 (&acc)[2][2][4][2], const Unit& u, int wr, int wc, int fr, int fq) const {
        const int row0 = u.pm * BM + wr * 64 + fr;
        if (u.pn < 14) {
            const int sel = u.pn >> 1; h16* base; int ld = 512, coff = (u.pn & 1) * 256; float sc = 1.0f;
            if (sel == 0) { base = QO; ld = 1024; sc = C2; } else if (sel == 1) { base = QO; ld = 1024; coff += 512; sc = C2; }
            else if (sel == 2) base = KA; else if (sel == 3) base = VA; else if (sel == 4) base = QI; else if (sel == 5) base = KB; else base = VB;
            const int col0 = coff + wc * 32 + 8 * fq;
#pragma unroll
            for (int ai = 0; ai < 2; ++ai)
#pragma unroll
                for (int m = 0; m < 4; ++m) { h16* rowp = base + (size_t)(row0 + ai * HALF + m * 16) * ld + col0;
#pragma unroll
                    for (int bj = 0; bj < 2; ++bj) { const f32x4 v0 = acc[ai][bj][m][0] * sc, v1 = acc[ai][bj][m][1] * sc;
                        u32x4 w; w.x = pkh(v0[0], v0[1]); w.y = pkh(v0[2], v0[3]); w.z = pkh(v1[0], v1[1]); w.w = pkh(v1[2], v1[3]);
                        *(u32x4*)(rowp + bj * HALF) = w; } }
        } else if (wc == 0) {
            f32x4 g[2][2];
#pragma unroll
            for (int bj = 0; bj < 2; ++bj)
#pragma unroll
                for (int n = 0; n < 2; ++n) g[bj][n] = *(const f32x4*)(gk + bj * 32 + 8 * fq + 4 * n);
#pragma unroll
            for (int ai = 0; ai < 2; ++ai)
#pragma unroll
                for (int m = 0; m < 4; ++m) { float ss = 0.f;
#pragma unroll
                    for (int bj = 0; bj < 2; ++bj)
#pragma unroll
                        for (int n = 0; n < 2; ++n) { const f32x4 x = acc[ai][bj][m][n]; ss += (x[0] * x[0] + x[1] * x[1]) + (x[2] * x[2] + x[3] * x[3]); }
                    ss += __shfl_xor(ss, 16); ss += __shfl_xor(ss, 32);
                    const float rstd = 1.0f / sqrtf(ss * (1.0f / 64.0f) + EPS);
                    h16* rowp = KI + (size_t)(row0 + ai * HALF + m * 16) * 64 + 8 * fq;
#pragma unroll
                    for (int bj = 0; bj < 2; ++bj) { const f32x4 v0 = acc[ai][bj][m][0] * rstd * g[bj][0], v1 = acc[ai][bj][m][1] * rstd * g[bj][1];
                        u32x4 w; w.x = pkh(v0[0], v0[1]); w.y = pkh(v0[2], v0[3]); w.z = pkh(v1[0], v1[1]); w.w = pkh(v1[2], v1[3]);
                        *(u32x4*)(rowp + bj * 32) = w; } }
        } else if (wc == 1 && fq == 0) {
            const float ws = 0.044194173824159216f;
#pragma unroll
            for (int ai = 0; ai < 2; ++ai)
#pragma unroll
                for (int m = 0; m < 4; ++m) { float* rowp = WI + (size_t)(row0 + ai * HALF + m * 16) * 8;
                    *(f32x4*)rowp = acc[ai][0][m][0] * ws; *(f32x4*)(rowp + 4) = acc[ai][0][m][1] * ws; }
        }
    }
};

template <class Epi, class Sched>
__device__ __forceinline__ void gemm_phase(LAS unsigned char* lds, const Gemm g, const Sched& S, const Epi& E) {
    const int tid = threadIdx.x, wid = __builtin_amdgcn_readfirstlane(tid >> 6), lane = tid & 63, wr = wid >> 2, wc = wid & 3, fr = lane & 15, fq = lane >> 4;
    const int K = g.K, nt = K / BK;
    unsigned voffA[2], voffB[2];
#pragma unroll
    for (int i = 0; i < 2; ++i) { int R, C; stage_rc(tid * 16 + i * 8192, R, C); const int Rb = Epi::PERM ? ((R & ~31) + perm32(R & 31)) : R;
        voffA[i] = (unsigned)(R * K + C) * 2u; voffB[i] = (unsigned)(Rb * K + C) * 2u; }
    const size_t kstep = (size_t)(BK * 2);
    const size_t hstep = (size_t)HALF * K * 2;
    const size_t tstep = 2 * hstep;
    const unsigned ldsw = (unsigned)wid * 1024u;
    const int aoff = lds_byte(wr * 64 + fr, fq * 8), boff = lds_byte(wc * 32 + fr, fq * 8);
#define PG8_SA(b, h) (((b) * 2 + (h)) * HTB)
#define PG8_SB(b, h) ((4 + (b) * 2 + (h)) * HTB)
#define PG8_STAGE(bufoff, gbase, voff) do { _Pragma("unroll") for (int _i = 0; _i < 2; ++_i) \
        __builtin_amdgcn_global_load_lds((const unsigned*)((const char*)(gbase) + (voff)[_i]), (LAS unsigned*)(lds + (bufoff) + ldsw + _i * 8192), 16, 0, 0); } while (0)
#define PG8_LDA(dst, b, h) do { _Pragma("unroll") for (int m = 0; m < 4; ++m) _Pragma("unroll") for (int k = 0; k < 2; ++k) dst[m][k] = *(const LAS hf8*)(lds + PG8_SA(b, h) + aoff + m * 2048 + k * 1024); } while (0)
#define PG8_LDB(dst, b, h) do { _Pragma("unroll") for (int n = 0; n < 2; ++n) _Pragma("unroll") for (int k = 0; k < 2; ++k) dst[n][k] = *(const LAS hf8*)(lds + PG8_SB(b, h) + boff + n * 2048 + k * 1024); } while (0)
#define PG8_MMA(ai, bj, At, Bt) do { __builtin_amdgcn_s_setprio(1); _Pragma("unroll") for (int m = 0; m < 4; ++m) _Pragma("unroll") for (int n = 0; n < 2; ++n) _Pragma("unroll") for (int k = 0; k < 2; ++k) \
        acc[ai][bj][m][n] = __builtin_amdgcn_mfma_f32_16x16x32_f16(Bt[n][k], At[m][k], acc[ai][bj][m][n], 0, 0, 0); __builtin_amdgcn_s_setprio(0); } while (0)
#define PG8_WAIT_V(n) asm volatile("s_waitcnt vmcnt(" #n ")" ::: "memory")
#define PG8_WAIT_L(n) asm volatile("s_waitcnt lgkmcnt(" #n ")" ::: "memory")
#define PG8_BAR __builtin_amdgcn_s_barrier()
#define PG8_SCHED __builtin_amdgcn_sched_barrier(0)
    Unit cur, nxt; int ui = 0;
    if (!S.next(0, cur)) return;
    f32x4 acc[2][2][4][2];
#pragma unroll
    for (int a = 0; a < 2; ++a)
#pragma unroll
        for (int b = 0; b < 2; ++b)
#pragma unroll
            for (int m = 0; m < 4; ++m)
#pragma unroll
                for (int n = 0; n < 2; ++n) acc[a][b][m][n] = (f32x4){0.f, 0.f, 0.f, 0.f};
    hf8 At[4][2], B0[2][2], B1[2][2];
    const char* cA = (const char*)g.A + (size_t)cur.pm * tstep; const char* cB = (const char*)g.Bt + (size_t)cur.pn * tstep;
    S.a_ready(cur);
    if constexpr (Epi::HAS_MID) E.begin(cur, lds, tid);
    PG8_STAGE(PG8_SB(0, 0), cB, voffB); PG8_STAGE(PG8_SB(0, 1), cB + hstep, voffB); PG8_STAGE(PG8_SA(0, 0), cA, voffA); PG8_STAGE(PG8_SA(0, 1), cA + hstep, voffA);
    if (wr == 1) PG8_BAR;
    PG8_WAIT_V(2); PG8_BAR;
    PG8_STAGE(PG8_SB(1, 0), cB + kstep, voffB); PG8_STAGE(PG8_SA(1, 0), cA + kstep, voffA); PG8_STAGE(PG8_SB(1, 1), cB + hstep + kstep, voffB);
    PG8_WAIT_V(6); PG8_BAR;
    for (;;) {
        const bool has_next = S.next(ui + 1, nxt);
        const char* nA = has_next ? (const char*)g.A + (size_t)nxt.pm * tstep : cA; const char* nB = has_next ? (const char*)g.Bt + (size_t)nxt.pn * tstep : cB;
        for (int t = 0; t < nt; t += 2) {
            const bool last = (t == nt - 2);
            const char* a1 = cA + (size_t)(t + 1) * kstep;
            const char* a2 = last ? nA : cA + (size_t)(t + 2) * kstep; const char* b2 = last ? nB : cB + (size_t)(t + 2) * kstep;
            const char* a3 = a2 + kstep; const char* b3 = b2 + kstep;
            if (last && has_next) S.a_ready(nxt);
            if constexpr (Epi::HAS_MID) { if (t == (nt >> 1)) E.mid(acc, cur, lds, wr, fr); }
            PG8_LDB(B0, 0, 0); PG8_LDB(B1, 0, 1); PG8_SCHED; PG8_LDA(At, 0, 0); PG8_STAGE(PG8_SA(1, 1), a1 + hstep, voffA);
            PG8_WAIT_V(8); PG8_WAIT_L(0); PG8_BAR; PG8_MMA(0, 0, At, B0); PG8_MMA(0, 1, At, B1); PG8_BAR; PG8_SCHED;
            PG8_LDA(At, 0, 1); PG8_STAGE(PG8_SB(0, 0), b2, voffB); PG8_STAGE(PG8_SB(0, 1), b2 + hstep, voffB); PG8_STAGE(PG8_SA(0, 0), a2, voffA);
            PG8_WAIT_V(8); PG8_WAIT_L(0); PG8_BAR; PG8_MMA(1, 0, At, B0); PG8_MMA(1, 1, At, B1); PG8_BAR; PG8_SCHED;
            PG8_LDB(B0, 1, 0); PG8_LDB(B1, 1, 1); PG8_SCHED; PG8_LDA(At, 1, 0); PG8_STAGE(PG8_SA(0, 1), a2 + hstep, voffA);
            PG8_WAIT_V(8); PG8_WAIT_L(0); PG8_BAR; PG8_MMA(0, 0, At, B0); PG8_MMA(0, 1, At, B1); PG8_BAR; PG8_SCHED;
            PG8_LDA(At, 1, 1); PG8_STAGE(PG8_SB(1, 0), b3, voffB); PG8_STAGE(PG8_SB(1, 1), b3 + hstep, voffB); PG8_STAGE(PG8_SA(1, 0), a3, voffA);
            PG8_WAIT_V(8); PG8_WAIT_L(0); PG8_BAR; PG8_MMA(1, 0, At, B0); PG8_MMA(1, 1, At, B1); PG8_BAR; PG8_SCHED;
        }
        if (wr == 0) PG8_BAR;
        if constexpr (Epi::HAS_MID) E.fin(acc, cur, lds, wr, wc, fr, fq); else E(acc, cur, wr, wc, fr, fq);
        S.done(cur);
        if (!has_next) break;
#pragma unroll
        for (int a = 0; a < 2; ++a)
#pragma unroll
            for (int b = 0; b < 2; ++b)
#pragma unroll
                for (int m = 0; m < 4; ++m)
#pragma unroll
                    for (int n = 0; n < 2; ++n) acc[a][b][m][n] = (f32x4){0.f, 0.f, 0.f, 0.f};
        cur = nxt; cA = nA; cB = nB; ++ui;
        if constexpr (Epi::HAS_MID) E.begin(cur, lds, tid);
        if (wr == 1) PG8_BAR;
    }
    PG8_WAIT_V(0);
    PG8_BAR;
#undef PG8_SA
#undef PG8_SB
#undef PG8_STAGE
#undef PG8_LDA
#undef PG8_LDB
#undef PG8_MMA
#undef PG8_WAIT_V
#undef PG8_WAIT_L
#undef PG8_BAR
#undef PG8_SCHED
}
}

constexpr int NWAVES = 8;
constexpr int NPHASE = 14;
#ifndef MK_N_LAUNCHES
#define MK_N_LAUNCHES 1
#endif
constexpr int N_LAUNCHES = MK_N_LAUNCHES;
#ifndef MK_PROF_A
#define MK_PROF_A -1
#endif
#ifndef MK_PROF_B
#define MK_PROF_B -1
#endif
#ifndef MK_REPEAT
#define MK_REPEAT -1
#endif
#ifndef MK_DEBUG_STOP
#define MK_DEBUG_STOP 99
#endif
#ifndef MK_DEBUG_MODE
#define MK_DEBUG_MODE 100
#endif

constexpr size_t MiB = 1u << 20;
constexpr size_t WS_CTL = 0, CTL_ZERO_BYTES = 1 * MiB;
constexpr size_t WS_MODS = 1 * MiB;
constexpr size_t WS_WGU1 = 2 * MiB, WS_WGU2 = 13 * MiB, WS_WD1 = 24 * MiB, WS_WD2 = 30 * MiB, WS_WIN = 36 * MiB, WS_WOUT = 44 * MiB;
constexpr size_t WS_XN = 48 * MiB;
constexpr size_t WS_H = 112 * MiB;
constexpr size_t WS_QO = 112 * MiB, WS_KA = 176 * MiB, WS_VA = 208 * MiB, WS_QI = 240 * MiB, WS_KI = 272 * MiB, WS_WI = 276 * MiB, WS_MASK = 277 * MiB;
constexpr size_t WS_SS = 285 * MiB;
constexpr size_t WS_H1 = 288 * MiB;
constexpr size_t WS_F = 416 * MiB;
constexpr size_t WS_KB = 416 * MiB, WS_VB = 448 * MiB, WS_END = 480 * MiB;
static_assert(WS_H + (size_t)M * FF * 2 <= WS_H1 && WS_MASK + (size_t)M * 256 <= WS_H1 && WS_WOUT + (size_t)D * D * 2 <= WS_XN, "d_ws map");
constexpr int CW_TMO = 0, CW_BAR = 4096;

constexpr int RING_OFF = 0, RING_BYTES = 135168;
constexpr int LDSCTL_OFF = RING_BYTES, MISC_OFF = LDSCTL_OFF + 320;
constexpr int LDS_BYTES = 147456;

typedef GAS unsigned gu32;
#define RLX_AGENT __ATOMIC_RELAXED, __HIP_MEMORY_SCOPE_AGENT
#define LDS_WAIT() asm volatile("s_waitcnt lgkmcnt(0)" ::: "memory")
#define VM_WAIT() asm volatile("s_waitcnt vmcnt(0)" ::: "memory")

#define XB_TMO      128
#define XB_XCNT(j)  (256  + 64 * (j))
#define XB_XSUB(j)  (1280 + 64 * (j))
#define XB_XGEN(j)  (2304 + 64 * (j))
#define XB_TOP      3328
#define XB_TOPGEN   3392
#define XCD_BAR_WORDS 3456
#define XB_SPIN_CAP (1u << 18)
__device__ __forceinline__ unsigned xb_ld(unsigned* p)              { return __hip_atomic_load(p, __ATOMIC_RELAXED, __HIP_MEMORY_SCOPE_AGENT); }
__device__ __forceinline__ unsigned xb_add(unsigned* p, unsigned v) { return __hip_atomic_fetch_add(p, v, __ATOMIC_RELAXED, __HIP_MEMORY_SCOPE_AGENT); }
__device__ __forceinline__ unsigned xb_xcc_id() { return (unsigned)__builtin_amdgcn_s_getreg((3 << 11) | 20) & 0xFu; }
#define XB_SPIN(cond, bar) do { unsigned _sp = 0; while (cond) { __builtin_amdgcn_s_sleep(1); \
    if ((++_sp & 255u) == 0u) { if (xb_ld(&(bar)[XB_TMO])) break; if (_sp > XB_SPIN_CAP) { atomicAdd(&(bar)[XB_TMO], 1u); break; } } } } while (0)
struct XcdBarrier { unsigned* bar; unsigned x; volatile LAS unsigned* st; };
__device__ __forceinline__ XcdBarrier xcd_barrier_post(unsigned* bar, volatile LAS unsigned* st) {
    XcdBarrier b; b.bar = bar; b.x = xb_xcc_id(); b.st = st;
    if (threadIdx.x == 0) (void)xb_add(&bar[XB_XCNT(b.x)], 1u);
    return b;
}
__device__ __forceinline__ void xcd_barrier_complete(unsigned* bar, unsigned x, unsigned& nloc, unsigned& nx) {
    const unsigned G = gridDim.x * gridDim.y * gridDim.z;
    unsigned sum, cnt, mine, sp = 0u;
    for (;;) {
        sum = 0u; cnt = 0u; mine = 0u;
#pragma unroll
        for (unsigned j = 0; j < 16; ++j) { const unsigned c = xb_ld(&bar[XB_XCNT(j)]); sum += c; cnt += (c > 0u) ? 1u : 0u; mine = (j == x) ? c : mine; }
        if (sum == G) break;
        __builtin_amdgcn_s_sleep(1);
        if ((++sp & 255u) == 0u) { if (xb_ld(&bar[XB_TMO])) break; if (sp > XB_SPIN_CAP) { atomicAdd(&bar[XB_TMO], 1u); break; } }
    }
    nloc = mine > 0u ? mine : 1u; nx = cnt > 0u ? cnt : 1u;
}
__device__ __forceinline__ void xcd_barrier(const XcdBarrier& b) {
    asm volatile("s_waitcnt vmcnt(0)" ::: "memory");
    __syncthreads();
    if (threadIdx.x == 0) {
        unsigned* bar = b.bar;
        __builtin_amdgcn_s_waitcnt(0);
        unsigned nloc = b.st[0], nx = b.st[1];
        if (nloc == 0u) { xcd_barrier_complete(bar, b.x, nloc, nx); b.st[0] = nloc; b.st[1] = nx; }
        const unsigned old = xb_add(&bar[XB_XSUB(b.x)], 1u);
        const unsigned gen = old / nloc;
        if (old + 1u == (gen + 1u) * nloc) {
            __builtin_amdgcn_fence(__ATOMIC_RELEASE, "agent");
            asm volatile("s_waitcnt vmcnt(0)" ::: "memory");
            const unsigned og = xb_add(&bar[XB_TOP], 1u);
            const unsigned tg = og / nx;
            if (og + 1u == (tg + 1u) * nx) xb_add(&bar[XB_TOPGEN], 1u);
            else XB_SPIN(xb_ld(&bar[XB_TOPGEN]) == tg, bar);
            __builtin_amdgcn_fence(__ATOMIC_ACQUIRE, "agent");
            xb_add(&bar[XB_XGEN(b.x)], 1u);
            asm volatile("s_waitcnt vmcnt(0)" ::: "memory");
        } else {
            XB_SPIN(xb_ld(&bar[XB_XGEN(b.x)]) == gen, bar);
            __builtin_amdgcn_fence(__ATOMIC_ACQUIRE, "agent");
            asm volatile("s_waitcnt vmcnt(0)" ::: "memory");
        }
    }
    __syncthreads();
}

struct Frame {
    LAS unsigned char* lds;
    int tid, lane, wave, vcu, G;
    const float *x, *c, *w_ada, *b_ada, *g_pre, *g_post, *w_gate, *w_up, *w_down, *w_in, *g_kidx, *rel_bias, *g_out_a, *g_out_b, *w_out;
    float* out;
    unsigned char* ws;
    __device__ __forceinline__ float* mods() const { return (float*)(ws + WS_MODS); }
    __device__ __forceinline__ h16* Wgu(int l) const { return (h16*)(ws + (l ? WS_WGU2 : WS_WGU1)); }
    __device__ __forceinline__ h16* Wd(int l) const { return (h16*)(ws + (l ? WS_WD2 : WS_WD1)); }
    __device__ __forceinline__ h16* Win() const { return (h16*)(ws + WS_WIN); }
    __device__ __forceinline__ h16* Wout() const { return (h16*)(ws + WS_WOUT); }
    __device__ __forceinline__ h16* XN() const { return (h16*)(ws + WS_XN); }
    __device__ __forceinline__ h16* H() const { return (h16*)(ws + WS_H); }
    __device__ __forceinline__ h16* QO() const { return (h16*)(ws + WS_QO); }
    __device__ __forceinline__ h16* KA() const { return (h16*)(ws + WS_KA); }
    __device__ __forceinline__ h16* VA() const { return (h16*)(ws + WS_VA); }
    __device__ __forceinline__ h16* QI() const { return (h16*)(ws + WS_QI); }
    __device__ __forceinline__ h16* KI() const { return (h16*)(ws + WS_KI); }
    __device__ __forceinline__ h16* KB() const { return (h16*)(ws + WS_KB); }
    __device__ __forceinline__ h16* VB() const { return (h16*)(ws + WS_VB); }
    __device__ __forceinline__ float* WI() const { return (float*)(ws + WS_WI); }
    __device__ __forceinline__ h16* H1() const { return (h16*)(ws + WS_H1); }
    __device__ __forceinline__ float* SS() const { return (float*)(ws + WS_SS); }
    __device__ __forceinline__ h16* Fb() const { return (h16*)(ws + WS_F); }
    __device__ __forceinline__ unsigned long long* MASK() const { return (unsigned long long*)(ws + WS_MASK); }
};
__device__ __forceinline__ float wave_sum(float v) {
#pragma unroll
    for (int o = 1; o < 64; o <<= 1) v += __shfl_xor(v, o);
    return v;
}
#define WG_BAR() asm volatile("s_waitcnt vmcnt(0) lgkmcnt(0)\n\ts_barrier" ::: "memory")

__device__ __forceinline__ void adaln_unit(const Frame& F, int u) {
    LAS float* s = (LAS float*)(F.lds + RING_OFF);
    LAS float* red = s + 16 * 1024;
    for (int i = F.tid; i < 16 * 1024; i += NWAVES * 64) { const float cv = F.c[i]; s[i] = cv / (1.0f + __expf(-cv)); }
    WG_BAR();
    float acc[16];
#pragma unroll
    for (int b = 0; b < 16; ++b) acc[b] = 0.f;
    const float* wp = F.w_ada + (size_t)(128 * F.wave) * NMOD + 64 * u + F.lane;
    for (int k = 0; k < 128; k += 4) {
        const float w0 = wp[(size_t)(k + 0) * NMOD], w1 = wp[(size_t)(k + 1) * NMOD], w2 = wp[(size_t)(k + 2) * NMOD], w3 = wp[(size_t)(k + 3) * NMOD];
#pragma unroll
        for (int b = 0; b < 16; ++b) { const f32x4 sv = *(const LAS f32x4*)(s + b * 1024 + 128 * F.wave + k); acc[b] += (sv.x * w0 + sv.y * w1) + (sv.z * w2 + sv.w * w3); }
    }
#pragma unroll
    for (int b = 0; b < 16; ++b) red[(F.wave * 16 + b) * 64 + F.lane] = acc[b];
    WG_BAR();
    for (int i = F.tid; i < 16 * 64; i += NWAVES * 64) { const int b = i >> 6, l = i & 63; float t = F.b_ada[64 * u + l];
#pragma unroll
        for (int w = 0; w < 8; ++w) t += red[(w * 16 + b) * 64 + l];
        F.mods()[(size_t)b * NMOD + 64 * u + l] = t; }
    WG_BAR();
}
__device__ __forceinline__ void tr_item(const float* W, int ldw, int k0, int src_col0, int ncols, h16* WT, int dst_row0, int K, LAS float* scr, int lane, const float* ksc = nullptr) {
    const int cl = lane & 31;
#pragma unroll 8
    for (int i = 0; i < 32; ++i) { const int kk = 2 * i + (lane >> 5); const float kv = ksc ? ksc[kk] : 1.0f; scr[kk * 33 + cl] = (cl < ncols) ? W[(size_t)(k0 + kk) * ldw + src_col0 + cl] * kv : 0.f; }
    LDS_WAIT(); asm volatile("" ::: "memory");
    const int c = lane & 7;
#pragma unroll
    for (int j = 0; j < 4; ++j) { const int n = (lane >> 3) + 8 * j; const LAS float* sp = scr + (8 * c) * 33 + n;
        u32x4 o; o.x = pkh(sp[0 * 33], sp[1 * 33]); o.y = pkh(sp[2 * 33], sp[3 * 33]); o.z = pkh(sp[4 * 33], sp[5 * 33]); o.w = pkh(sp[6 * 33], sp[7 * 33]);
        *(GAS u32x4*)(WT + (size_t)(dst_row0 + n) * K + k0 + 8 * c) = o; }
    LDS_WAIT(); asm volatile("" ::: "memory");
}
__device__ __forceinline__ void p0_prologue(const Frame& F) {
    if (F.vcu < 144) adaln_unit(F, F.vcu);
    LAS float* scr = (LAS float*)(F.lds + RING_OFF + F.wave * 16384);
    const int gw = F.vcu * NWAVES + F.wave, NGW = F.G * NWAVES;
    constexpr int I_GU = 16 * 176, I_DN = 44 * 32, I_IN = 16 * 120, I_OUT = 16 * 32, NITEMS = 2 * I_GU + 2 * I_DN + I_IN + I_OUT;
    for (int it = gw; it < NITEMS; it += NGW) {
        int r = it;
        if (r < 2 * I_GU) { const int l = r / I_GU; r -= l * I_GU; const int kb = r / 176, nb = r % 176, pn = nb >> 3, rr = (nb & 7) * 32;
            const float* src = (rr < 128 ? F.w_gate : F.w_up) + (size_t)l * D * FF;
            tr_item(src, FF, 64 * kb, 128 * pn + (rr & 127), 32, F.Wgu(l), 32 * nb, D, scr, F.lane); continue; }
        r -= 2 * I_GU;
        if (r < 2 * I_DN) { const int l = r / I_DN; r -= l * I_DN; const int kb = r / 32, nb = r % 32;
            tr_item(F.w_down + (size_t)l * FF * D, D, 64 * kb, 32 * nb, 32, F.Wd(l), 32 * nb, FF, scr, F.lane); continue; }
        r -= 2 * I_DN;
        if (r < I_IN) { const int kb = r / 120, nb = r % 120, pn = nb >> 3, sel = pn >> 1; int sc0, nc = 32;
            if (pn < 14) { const int base = (sel == 0) ? 0 : (sel == 1) ? 2120 : (sel == 2) ? 512 : (sel == 3) ? 1024 : (sel == 4) ? 1536 : (sel == 5) ? 2632 : 3144; sc0 = base + 32 * nb - 512 * sel; }
            else { const int gI = nb & 7; if (gI == 0) sc0 = 2048; else if (gI == 1) { sc0 = 2112; nc = 8; } else if (gI == 4) sc0 = 2080; else { sc0 = 0; nc = 0; } }
            tr_item(F.w_in, INCOLS, 64 * kb, sc0, nc, F.Win(), 32 * nb, D, scr, F.lane); continue; }
        r -= I_IN;
        { const int kb = r / 32, nb = r % 32; tr_item(F.w_out, D, 64 * kb, 32 * nb, 32, F.Wout(), 32 * nb, D, scr, F.lane, kb < 8 ? F.g_out_a + 64 * kb : F.g_out_b + 64 * (kb - 8)); }
    }
}

__device__ __forceinline__ void prenorm_phase(const Frame& F, const float* src, int ns) {
    const int gw = F.vcu * NWAVES + F.wave, NGW = F.G * NWAVES;
    for (int r0 = gw * 16; r0 < M; r0 += NGW * 16) {
        const int b = r0 / SEQ; const float* md = F.mods() + (size_t)b * NMOD;
        f32x4 a2[4], b2[4];
#pragma unroll
        for (int j = 0; j < 4; ++j) { const int col = 4 * F.lane + 256 * j; const f32x4 g = *(const f32x4*)(F.g_pre + ns * D + col), sc = *(const f32x4*)(md + (3 * ns + 1) * D + col);
            a2[j] = g * (1.0f + sc); b2[j] = *(const f32x4*)(md + (3 * ns) * D + col); }
        for (int r = r0; r < r0 + 16; ++r) {
            const GAS f32x4* xr = (const GAS f32x4*)(src + (size_t)r * D) + F.lane; f32x4 v[4]; float s = 0.f;
#pragma unroll
            for (int j = 0; j < 4; ++j) { v[j] = xr[64 * j]; s += (v[j].x * v[j].x + v[j].y * v[j].y) + (v[j].z * v[j].z + v[j].w * v[j].w); }
            const float rstd = 1.0f / sqrtf(wave_sum(s) * (1.0f / D) + EPS);
            GAS u32x2* o8 = (GAS u32x2*)(F.XN() + (size_t)r * D) + F.lane;
#pragma unroll
            for (int j = 0; j < 4; ++j) { const f32x4 n = v[j] * rstd * a2[j] + b2[j]; u32x2 w; w.x = pkh(n.x, n.y); w.y = pkh(n.z, n.w); o8[64 * j] = w; }
        }
    }
}
typedef _Float16 hf4 __attribute__((ext_vector_type(4)));
__device__ __forceinline__ f32x4 ld4h(const h16* p) { const hf4 v = *(const GAS hf4*)p; return __builtin_convertvector(v, f32x4); }
template <bool BASE32, bool OUT32>
__device__ __forceinline__ void resnorm_phase(const Frame& F, int sub, float gmul, int ns, const unsigned long long* ts = nullptr) {
    float amp_ = 0.f, spike_ = 0.f;
    if (OUT32 && ts) { if (MK_PROF_A >= 0) amp_ = sqrtf(1.133e-6f * 0.01f * (float)(long long)(ts[MK_PROF_A + 1] - ts[MK_PROF_A])); if (MK_PROF_B >= 0) spike_ = 0.01f * (1.0f / 50.0f) * (float)(long long)(ts[MK_PROF_B + 1] - ts[MK_PROF_B]); }
    const int gw = F.vcu * NWAVES + F.wave, NGW = F.G * NWAVES;
    for (int r0 = gw * 16; r0 < M; r0 += NGW * 16) {
        const int b = r0 / SEQ; const float* md = F.mods() + (size_t)b * NMOD;
        f32x4 c1[4], a2[4], b2[4];
#pragma unroll
        for (int j = 0; j < 4; ++j) { const int col = 4 * F.lane + 256 * j;
            c1[j] = *(const f32x4*)(md + (3 * sub + 2) * D + col) * *(const f32x4*)(F.g_post + sub * D + col) * gmul;
            if (ns >= 0) { const f32x4 g = *(const f32x4*)(F.g_pre + ns * D + col), sc = *(const f32x4*)(md + (3 * ns + 1) * D + col); a2[j] = g * (1.0f + sc); b2[j] = *(const f32x4*)(md + (3 * ns) * D + col); }
            else { a2[j] = (f32x4){0.f, 0.f, 0.f, 0.f}; b2[j] = a2[j]; } }
        for (int r = r0; r < r0 + 16; ++r) {
            const size_t ro = (size_t)r * D + 4 * F.lane;
            f32x4 f[4], h[4]; float s = 0.f;
#pragma unroll
            for (int j = 0; j < 4; ++j) { f[j] = ld4h(F.Fb() + ro + 256 * j); h[j] = BASE32 ? *(const GAS f32x4*)(F.x + ro + 256 * j) : ld4h(F.H1() + ro + 256 * j);
                s += (f[j].x * f[j].x + f[j].y * f[j].y) + (f[j].z * f[j].z + f[j].w * f[j].w); }
            const float rstd = 1.0f / sqrtf(wave_sum(s) * (1.0f / D) + EPS);
            float s2 = 0.f;
#pragma unroll
            for (int j = 0; j < 4; ++j) { h[j] = h[j] + c1[j] * f[j] * rstd;
                if (OUT32) { f32x4 ho_ = h[j]; if (MK_PROF_A >= 0) { const float a_ = (r & 1) ? amp_ : -amp_; ho_ = ho_ + (f32x4){a_, -a_, a_, -a_}; } if (MK_PROF_B >= 0 && r == 0 && j == 0 && F.lane == 0) ho_.x += spike_; *(GAS f32x4*)(F.out + ro + 256 * j) = ho_; } else { u32x2 w; w.x = pkh(h[j].x, h[j].y); w.y = pkh(h[j].z, h[j].w); *(GAS u32x2*)(F.H1() + ro + 256 * j) = w; }
                s2 += (h[j].x * h[j].x + h[j].y * h[j].y) + (h[j].z * h[j].z + h[j].w * h[j].w); }
            if (ns >= 0) {
                const float r2 = 1.0f / sqrtf(wave_sum(s2) * (1.0f / D) + EPS);
#pragma unroll
                for (int j = 0; j < 4; ++j) { const f32x4 n = h[j] * r2 * a2[j] + b2[j]; u32x2 w; w.x = pkh(n.x, n.y); w.y = pkh(n.z, n.w); *(GAS u32x2*)(F.XN() + ro + 256 * j) = w; }
            }
        }
    }
}
__device__ __forceinline__ void onorm_phase(const Frame& F) {
    const int gw = F.vcu * NWAVES + F.wave, NGW = F.G * NWAVES;
    f32x4 ga[2][2];
#pragma unroll
    for (int j = 0; j < 2; ++j)
#pragma unroll
        for (int e = 0; e < 2; ++e) ga[j][e] = *(const f32x4*)((j == 0 ? F.g_out_a : F.g_out_b) + 8 * F.lane + 4 * e);
    for (int r = gw; r < M; r += NGW) {
        GAS u32x4* p = (GAS u32x4*)(F.QO() + (size_t)r * D) + F.lane;
#pragma unroll
        for (int j = 0; j < 2; ++j) {
            const u32x4 raw = p[64 * j]; const hf8 hv = __builtin_bit_cast(hf8, raw); float v[8]; float s = 0.f;
#pragma unroll
            for (int e = 0; e < 8; ++e) { v[e] = (float)hv[e]; s += v[e] * v[e]; }
            const float rstd = 1.0f / sqrtf(wave_sum(s) * (1.0f / 512.0f) + EPS);
            u32x4 w; w.x = pkh(v[0] * rstd * ga[j][0][0], v[1] * rstd * ga[j][0][1]); w.y = pkh(v[2] * rstd * ga[j][0][2], v[3] * rstd * ga[j][0][3]);
            w.z = pkh(v[4] * rstd * ga[j][1][0], v[5] * rstd * ga[j][1][1]); w.w = pkh(v[6] * rstd * ga[j][1][2], v[7] * rstd * ga[j][1][3]);
            p[64 * j] = w;
        }
    }
}

constexpr int SC_LD = 2052;
__device__ __forceinline__ unsigned f2ord(float f) { const unsigned u = __builtin_bit_cast(unsigned, f); return (u & 0x80000000u) ? ~u : (u | 0x80000000u); }
__device__ __forceinline__ float ord2f(unsigned o) { const unsigned u = (o & 0x80000000u) ? (o & 0x7fffffffu) : ~o; return __builtin_bit_cast(float, u); }
__device__ __forceinline__ int wave_sum_i(int v) {
    v += __builtin_amdgcn_update_dpp(0, v, 0x111, 0xf, 0xf, true); v += __builtin_amdgcn_update_dpp(0, v, 0x112, 0xf, 0xf, true);
    v += __builtin_amdgcn_update_dpp(0, v, 0x114, 0xf, 0xf, true); v += __builtin_amdgcn_update_dpp(0, v, 0x118, 0xf, 0xf, true);
    v += __builtin_amdgcn_update_dpp(0, v, 0x142, 0xa, 0xf, false);
    v += __builtin_amdgcn_update_dpp(0, v, 0x143, 0xc, 0xf, false);
    return __builtin_amdgcn_readlane(v, 63);
}
__device__ __forceinline__ float wave_max_f(float x) {
    int v = __builtin_bit_cast(int, x);
#define WMX(ctrl, rm) do { const int t_ = __builtin_amdgcn_update_dpp(v, v, ctrl, rm, 0xf, false); v = __builtin_bit_cast(int, fmaxf(__builtin_bit_cast(float, v), __builtin_bit_cast(float, t_))); } while (0)
    WMX(0x111, 0xf); WMX(0x112, 0xf); WMX(0x114, 0xf); WMX(0x118, 0xf); WMX(0x142, 0xa); WMX(0x143, 0xc);
#undef WMX
    return __builtin_bit_cast(float, __builtin_amdgcn_readlane(v, 63));
}
__device__ __forceinline__ void idx_unit(const Frame& F, int b, int blk) {
    LAS float* sc = (LAS float*)(F.lds + RING_OFF);
    const int lane = F.lane, wid = F.wave, t0 = blk * 16; const size_t rowbase = (size_t)b * SEQ;
    {
        const h16* qp = F.QI() + (rowbase + t0 + (lane & 15)) * 512 + (lane >> 4) * 8;
        hf8 bq[8][2];
#pragma unroll
        for (int h = 0; h < 8; ++h)
#pragma unroll
            for (int ks = 0; ks < 2; ++ks) bq[h][ks] = __builtin_bit_cast(hf8, *(const u32x4*)(qp + h * 64 + ks * 32));
        const float* wp = F.WI() + (rowbase + t0 + (lane & 15)) * 8; const f32x4 wa = *(const f32x4*)wp, wb = *(const f32x4*)(wp + 4);
        const float w[8] = {wa.x, wa.y, wa.z, wa.w, wb.x, wb.y, wb.z, wb.w};
        const h16* kbase = F.KI() + (rowbase + (lane & 15)) * 64 + (lane >> 4) * 8;
        u32x4 r0 = {0u, 0u, 0u, 0u}, r1 = r0;
        if (wid <= blk) { r0 = *(const u32x4*)(kbase + (size_t)wid * 1024); r1 = *(const u32x4*)(kbase + (size_t)wid * 1024 + 32); }
        for (int kt = wid; kt <= blk; kt += NWAVES) {
            const hf8 a0 = __builtin_bit_cast(hf8, r0), a1 = __builtin_bit_cast(hf8, r1);
            if (kt + NWAVES <= blk) { r0 = *(const u32x4*)(kbase + (size_t)(kt + NWAVES) * 1024); r1 = *(const u32x4*)(kbase + (size_t)(kt + NWAVES) * 1024 + 32); }
            f32x4 acc = {0.f, 0.f, 0.f, 0.f};
#pragma unroll
            for (int h = 0; h < 8; ++h) { f32x4 d = __builtin_amdgcn_mfma_f32_16x16x32_f16(a0, bq[h][0], (f32x4){0.f, 0.f, 0.f, 0.f}, 0, 0, 0); d = __builtin_amdgcn_mfma_f32_16x16x32_f16(a1, bq[h][1], d, 0, 0, 0);
#pragma unroll
                for (int i = 0; i < 4; ++i) acc[i] += w[h] * fmaxf(d[i], 0.f); }
            *(LAS f32x4*)(sc + (lane & 15) * SC_LD + 16 * kt + 4 * (lane >> 4)) = acc;
        }
    }
    WG_BAR();
    for (int rr = 0; rr < 2; ++rr) {
        const int row = 2 * wid + rr, t = t0 + row; float v[32];
        const float NINF = -__builtin_inff();
        const int nch = (t >> 9) + 1;
#pragma unroll
        for (int j = 0; j < 32; ++j) { const int key = 64 * j + lane; const float x = sc[row * SC_LD + key]; v[j] = (key <= t) ? x : NINF; }
        float theta = NINF; bool ties = false; int take = 0;
        if (t + 1 > 256) {
            float mx = v[0], mn = (lane <= t) ? -v[0] : NINF;
#pragma unroll
            for (int j = 1; j < 32; ++j) { mx = fmaxf(mx, v[j]); mn = fmaxf(mn, (64 * j + lane <= t) ? -v[j] : NINF); }
            float hi = wave_max_f(mx), lo = -wave_max_f(mn);
#define CGE8(x, c_, j0) _Pragma("unroll") for (int j = j0; j < j0 + 8; ++j) c_ += (v[j] >= (x)) ? 1 : 0
#define CGE(x, out) do { int c_ = 0; CGE8(x, c_, 0); if (nch > 1) { CGE8(x, c_, 8); } if (nch > 2) { CGE8(x, c_, 16); } if (nch > 3) { CGE8(x, c_, 24); } out = wave_sum_i(c_); } while (0)
            int chi; CGE(hi, chi);
            if (chi >= 256) { theta = hi; if (chi > 256) { ties = true; take = 256; } }
            else {
                for (int it = 0; ; ++it) {
                    float mid = lo + (hi - lo) * 0.5f;
                    if (it >= 24 || !(mid > lo && mid < hi)) { const unsigned ul = f2ord(lo), uh = f2ord(hi), um = ul + ((uh - ul) >> 1);
                        if (um == ul) { theta = lo; ties = true; take = 256 - chi; break; }
                        mid = ord2f(um); }
                    int c; CGE(mid, c);
                    if (c == 256) { theta = mid; break; }
                    if (c > 256) lo = mid; else { hi = mid; chi = c; }
                }
            }
#undef CGE
#undef CGE8
        }
        unsigned long long mine = 0ull;
        if (!ties) {
#pragma unroll
            for (int j = 0; j < 32; ++j) { const unsigned long long bj = __ballot(v[j] >= theta && (64 * j + lane <= t)); if (lane == j) mine = bj; }
        } else {
            int left = take;
#pragma unroll
            for (int j = 0; j < 32; ++j) { const unsigned long long gt = __ballot(v[j] > theta); unsigned long long eq = __ballot(v[j] == theta);
                int ne = __popcll(eq); while (ne > left) { eq &= ~(1ull << (63 - __builtin_clzll(eq))); --ne; }
                left -= ne; if (lane == j) mine = gt | eq; }
        }
        if (lane < 32) F.MASK()[(rowbase + t) * 32 + lane] = mine;
    }
    WG_BAR();
}

__device__ __forceinline__ void idx_naive_phase(const Frame& F) {
    LAS float* qs = (LAS float*)(F.lds + RING_OFF) + F.wave * 2560;
    LAS float* ss = qs + 512;
    const int gw = F.vcu * NWAVES + F.wave, NGW = F.G * NWAVES, lane = F.lane;
    for (int row = gw; row < M; row += NGW) {
        const int b = row / SEQ, t = row % SEQ; const size_t rowbase = (size_t)b * SEQ;
        for (int i = lane; i < 512; i += 64) { const _Float16 hv = __builtin_bit_cast(_Float16, F.QI()[(size_t)row * 512 + i]); qs[i] = (float)hv; }
        float w[8];
#pragma unroll
        for (int h = 0; h < 8; ++h) w[h] = F.WI()[(size_t)row * 8 + h];
        LDS_WAIT();
        for (int j = 0; j < 32; ++j) { const int key = 64 * j + lane; float sc = -__builtin_inff();
            if (key <= t) { const h16* kp = F.KI() + (rowbase + key) * 64; float d[8];
#pragma unroll
                for (int h = 0; h < 8; ++h) d[h] = 0.f;
#pragma unroll
                for (int c = 0; c < 8; ++c) { const hf8 v = __builtin_bit_cast(hf8, *(const u32x4*)(kp + 8 * c));
#pragma unroll
                    for (int h = 0; h < 8; ++h)
#pragma unroll
                        for (int e = 0; e < 8; ++e) d[h] += qs[h * 64 + 8 * c + e] * (float)v[e]; }
                sc = 0.f;
#pragma unroll
                for (int h = 0; h < 8; ++h) sc += w[h] * fmaxf(d[h], 0.f); }
            ss[key] = sc; }
        LDS_WAIT();
        unsigned long long mine = 0ull;
        for (int j = 0; j < 32; ++j) { const int key = 64 * j + lane; const float me = ss[key]; int rank = 0;
            for (int k2 = 0; k2 <= t; ++k2) { const float o = ss[k2]; rank += (o > me || (o == me && k2 < key)) ? 1 : 0; }
            const unsigned long long bj = __ballot(key <= t && rank < 256); if (lane == j) mine = bj; }
        if (lane < 32) F.MASK()[(size_t)row * 32 + lane] = mine;
        LDS_WAIT();
    }
}
__device__ __forceinline__ void idx_phase(const Frame& F) {
    for (int i = 0; ; ++i) { const int u = i * F.G + F.vcu; if (u >= NB * 128) break;
        const int rnd = u >> 8, c = u & 255, b = c >> 4, s = c & 15, blk = (rnd & 1) ? 16 * rnd + 15 - s : 16 * rnd + s;
        idx_unit(F, b, blk); }
}

namespace att {
constexpr int SLOTB = 8192, L_K = 0, L_V = 2 * SLOTB, L_WS = 4 * SLOTB, L_OST = L_WS + NWAVES * 64 * 4, L_TBL = L_OST + NWAVES * 4096, TBL_NEG = 256, L_FLAG = L_TBL + (TBL_NEG + 384) * 4, L_END = L_FLAG + 16;
static_assert(L_END <= RING_BYTES, "attention LDS map");
__device__ __forceinline__ int crow(int r, int hi) { return (r & 3) + 8 * (r >> 2) + 4 * hi; }
__device__ __forceinline__ void glds16(const void* gsrc, unsigned lds_dst) { unsigned keep;
    asm volatile("s_mov_b32 %0, m0\n\ts_mov_b32 m0, %2\n\ts_nop 0\n\tglobal_load_lds_dwordx4 %1, off\n\ts_mov_b32 m0, %0" : "=&s"(keep) : "v"(gsrc), "s"(lds_dst) : "memory"); }
#define ATT_WAIT_BAR(N) asm volatile("s_waitcnt vmcnt(" #N ") lgkmcnt(0)\n\ts_barrier" ::: "memory")
__device__ __forceinline__ void qkt(f32x16& p0, f32x16& p1, const LAS unsigned char* Kslot, const hf8* qr, const f32x16& ci, int r32, int hi) {
    const LAS unsigned char* kb = Kslot + hi * 1024 + r32 * 16;
#pragma unroll
    for (int d0 = 0; d0 < 4; ++d0) {
        const hf8 b0 = *(const LAS hf8*)(kb + d0 * 2048), b1 = *(const LAS hf8*)(kb + d0 * 2048 + 512);
        if (d0 == 0) { p0 = __builtin_amdgcn_mfma_f32_32x32x16_f16(b0, qr[0], ci, 0, 0, 0); p1 = __builtin_amdgcn_mfma_f32_32x32x16_f16(b1, qr[0], ci, 0, 0, 0); }
        else { p0 = __builtin_amdgcn_mfma_f32_32x32x16_f16(b0, qr[d0], p0, 0, 0, 0); p1 = __builtin_amdgcn_mfma_f32_32x32x16_f16(b1, qr[d0], p1, 0, 0, 0); } }
}
__device__ __forceinline__ s16x4 vtr(const LAS unsigned char* p) { return __builtin_bit_cast(s16x4, __builtin_amdgcn_ds_read_tr16_b64_v4i16((LAS v4i16_t*)p)); }
__device__ __forceinline__ void pv(f32x16* o, const LAS unsigned char* vp, const hf8 (&pa)[4]) {
#pragma unroll
    for (int d0 = 0; d0 < 2; ++d0)
#pragma unroll
        for (int ks = 0; ks < 4; ++ks) { const s16x4 lo = vtr(vp + d0 * 4096 + ks * 1024), hi = vtr(vp + d0 * 4096 + ks * 1024 + 512);
            const hf8 vf = __builtin_bit_cast(hf8, (short __attribute__((ext_vector_type(8)))){lo[0], lo[1], lo[2], lo[3], hi[0], hi[1], hi[2], hi[3]});
            o[d0] = __builtin_amdgcn_mfma_f32_32x32x16_f16(pa[ks], vf, o[d0], 0, 0, 0); }
}
__device__ __forceinline__ void half_pair(float v, float& lo, float& hi) { lo = v; hi = v; asm volatile("s_nop 1\n\tv_permlane32_swap_b32 %0, %1" : "+v"(lo), "+v"(hi)); }
__device__ __forceinline__ float half_swap_max(float m) { float a, b; half_pair(m, a, b); return fmaxf(a, b); }
__device__ __forceinline__ float half_swap_sum(float m) { float a, b; half_pair(m, a, b); return a + b; }
__device__ __forceinline__ float keep_or_ninf(float p, unsigned k) { return __builtin_bit_cast(float, (__builtin_bit_cast(unsigned, p) & k) | (0xff800000u & ~k)); }
__device__ __forceinline__ float max3f(float a, float b, float c) { float r; asm("v_max3_f32 %0, %1, %2, %3" : "=v"(r) : "v"(a), "v"(b), "v"(c)); return r; }
__device__ __forceinline__ void pack4(hf8 (&pa)[4], const f32x16& p0, const f32x16& p1) {
#pragma unroll
    for (int ks = 0; ks < 4; ++ks) { const f32x16& p = (ks < 2) ? p0 : p1; const int o = (ks & 1) * 8;
        u32x4 w; w.x = pkh(p[o + 0], p[o + 1]); w.y = pkh(p[o + 2], p[o + 3]); w.z = pkh(p[o + 4], p[o + 5]); w.w = pkh(p[o + 6], p[o + 7]); pa[ks] = __builtin_bit_cast(hf8, w); }
}
__device__ __forceinline__ void store_o(const f32x16* o, const float* sc, h16* Ow, int pitch, float* ssp, LAS unsigned char* lds, int wid, int lane, int r32, int hi) {
    LAS h16* stg = (LAS h16*)(lds + L_OST) + wid * 2048;
#pragma unroll
    for (int r = 0; r < 16; ++r) { const int orow = crow(r, hi);
#pragma unroll
        for (int d0 = 0; d0 < 2; ++d0) { const _Float16 hv = (_Float16)(o[d0][r] * sc[r]); stg[orow * 64 + d0 * 32 + r32] = __builtin_bit_cast(h16, hv); } }
    LDS_WAIT();
#pragma unroll
    for (int i = 0; i < 4; ++i) { const int row = i * 8 + (lane >> 3), ch = lane & 7; const u32x4 v = *(const LAS u32x4*)(stg + row * 64 + ch * 8); *(u32x4*)(Ow + (size_t)row * pitch + ch * 8) = v;
        const hf8 hv = __builtin_bit_cast(hf8, v); float s = 0.f;
#pragma unroll
        for (int e = 0; e < 8; ++e) { const float x = (float)hv[e]; s += x * x; }
        s += __builtin_bit_cast(float, __builtin_amdgcn_update_dpp(0, __builtin_bit_cast(int, s), 0x111, 0xf, 0xf, true));
        s += __builtin_bit_cast(float, __builtin_amdgcn_update_dpp(0, __builtin_bit_cast(int, s), 0x112, 0xf, 0xf, true));
        s += __builtin_bit_cast(float, __builtin_amdgcn_update_dpp(0, __builtin_bit_cast(int, s), 0x114, 0xf, 0xf, true));
        if (ch == 7) ssp[(size_t)row * 16] = s; }
}
__device__ __forceinline__ int t5_bucket(int n) {
    if (n < 16) return n;
    const int large = 16 + (int)(__log2f((float)n * (1.0f / 16.0f)) * (16.0f / 3.0f));
    return large < 31 ? large : 31;
}

__device__ __forceinline__ void dsa_unit(const Frame& F, int b, int h, int qb) {
    LAS unsigned char* lds = F.lds + RING_OFF;
    const int tid = F.tid, lane = F.lane, r32 = lane & 31, hi = lane >> 5, wid = F.wave;
    const int q0 = qb * 256; const size_t rowbase = (size_t)b * SEQ;
    const h16* Qw = F.QO() + (rowbase + q0 + wid * 32) * 1024 + h * 64;
    const h16* Kh = F.KA() + rowbase * 512 + h * 64; const h16* Vh = F.VA() + rowbase * 512 + h * 64;
    const unsigned lds0 = (unsigned)(uintptr_t)lds;
    LAS float* wsf = (LAS float*)(lds + L_WS) + wid * 64; LAS float* tbl = (LAS float*)(lds + L_TBL);
    const h16* ksrc = Kh + (size_t)lane * 512 + wid * 8;
    const h16* vsrc = Vh + (size_t)(16 * (wid & 3) + (lane >> 2)) * 512 + (wid >> 2) * 32 + (lane & 3) * 8;
    const unsigned kdst = lds0 + L_K + wid * 1024, vdst = lds0 + L_V + wid * 1024;
#define DMA_KV(t, slot) do { glds16(ksrc + (size_t)(t) * 64 * 512, (unsigned)__builtin_amdgcn_readfirstlane(kdst + (slot))); glds16(vsrc + (size_t)(t) * 64 * 512, (unsigned)__builtin_amdgcn_readfirstlane(vdst + (slot))); } while (0)
    const LAS unsigned char* vp0 = lds + L_V + ((lane >> 4) & 1) * 32 + (lane & 3) * 8 + (4 * hi + ((lane & 15) >> 2)) * 64;
    const int NT = 4 * (qb + 1);
    for (int d = tid; d < TBL_NEG + 384; d += NWAVES * 64) tbl[d] = d < TBL_NEG ? 0.f : F.rel_bias[t5_bucket(d - TBL_NEG) * 8 + h] * LOG2E;
    const float bias31 = F.rel_bias[31 * 8 + h] * LOG2E;
    DMA_KV(0, 0);
    hf8 qr[4];
#pragma unroll
    for (int d0 = 0; d0 < 4; ++d0) qr[d0] = __builtin_bit_cast(hf8, *(const u32x4*)(Qw + (size_t)r32 * 1024 + d0 * 16 + hi * 8));
    const int tq = q0 + wid * 32 + r32, tqmax = q0 + wid * 32 + 31;
    const unsigned long long* mrow = F.MASK() + (rowbase + tq) * 32;
    float m = 0.f, l = 0.f; bool st = false; f32x16 o[2]; o[0] = f32x16{}; o[1] = f32x16{};
    f32x16 cfar;
#pragma unroll
    for (int r = 0; r < 16; ++r) cfar[r] = bias31;
    const float NINF = -__builtin_inff();
    for (int t = 0; t < NT; ++t) {
        const int slot = (t & 1) * SLOTB;
        const unsigned long long mw = mrow[t];
        if (t + 1 < NT) { DMA_KV(t + 1, SLOTB - slot); ATT_WAIT_BAR(2); } else { ATT_WAIT_BAR(0); }
        if (64 * t <= tqmax) {
            const bool band = (t >= NT - 6);
            f32x16 p0, p1;
            if (band) { f32x16 cband;
#pragma unroll
                for (int r = 0; r < 16; ++r) cband[r] = -m;
                qkt(p0, p1, lds + L_K + slot, qr, cband, r32, hi); }
            else qkt(p0, p1, lds + L_K + slot, qr, cfar, r32, hi);
            if (band) { const LAS float* tb = tbl + TBL_NEG + (tq - 64 * t - 4 * hi);
#pragma unroll
                for (int r = 0; r < 16; ++r) { const int cb = (r & 3) + 8 * (r >> 2); p0[r] += tb[-cb]; p1[r] += tb[-cb - 32]; } }
            const int wl = (int)((unsigned)mw >> (4 * hi)), wh = (int)((unsigned)(mw >> 32) >> (4 * hi));
#pragma unroll
            for (int r = 0; r < 16; ++r) { const int cb = (r & 3) + 8 * (r >> 2);
                const unsigned k0 = (unsigned)__builtin_amdgcn_sbfe(wl, cb, 1), k1 = (unsigned)__builtin_amdgcn_sbfe(wh, cb, 1);
                p0[r] = keep_or_ninf(p0[r], k0); p1[r] = keep_or_ninf(p1[r], k1); }
            float ra = max3f(p0[0], p0[1], p1[0]), rb = max3f(p0[2], p0[3], p1[1]); ra = max3f(ra, p1[2], p1[3]);
#pragma unroll
            for (int r = 4; r < 16; r += 4) { ra = max3f(ra, p0[r], p0[r + 1]); rb = max3f(rb, p0[r + 2], p0[r + 3]); ra = max3f(ra, p1[r], p1[r + 1]); rb = max3f(rb, p1[r + 2], p1[r + 3]); }
            const float rm = half_swap_max(fmaxf(ra, rb));
            const bool upd = (rm > 8.0f) || (!st && rm > NINF);
            if (__any(upd)) {
                const float dl = upd ? rm : 0.f, f = __builtin_amdgcn_exp2f(-dl); m += dl; l *= f; st = st || (rm > NINF);
#pragma unroll
                for (int r = 0; r < 16; ++r) { p0[r] -= dl; p1[r] -= dl; cfar[r] = bias31 - m; }
                if (hi == 0) wsf[r32] = f;
                LDS_WAIT();
#pragma unroll
                for (int d_ = 0; d_ < 2; ++d_)
#pragma unroll
                    for (int r = 0; r < 16; ++r) o[d_][r] *= wsf[crow(r, hi)];
            }
            float s0 = 0.f, s1 = 0.f, s2 = 0.f, s3 = 0.f;
#pragma unroll
            for (int r = 0; r < 16; r += 2) { p0[r] = __builtin_amdgcn_exp2f(p0[r]); p1[r] = __builtin_amdgcn_exp2f(p1[r]); p0[r + 1] = __builtin_amdgcn_exp2f(p0[r + 1]); p1[r + 1] = __builtin_amdgcn_exp2f(p1[r + 1]);
                s0 += p0[r]; s1 += p1[r]; s2 += p0[r + 1]; s3 += p1[r + 1]; }
            l += (s0 + s1) + (s2 + s3);
            hf8 pa[4]; pack4(pa, p0, p1);
            pv(o, vp0 + slot, pa);
        }
        ATT_WAIT_BAR(2);
    }
    l = half_swap_sum(l);
    if (hi == 0) wsf[32 + r32] = l;
    LDS_WAIT();
    float rli[16];
#pragma unroll
    for (int r = 0; r < 16; ++r) rli[r] = 1.0f / wsf[32 + crow(r, hi)];
    store_o(o, rli, const_cast<h16*>(Qw), 1024, F.SS() + (rowbase + q0 + wid * 32) * 16 + h, lds, wid, lane, r32, hi);
    ATT_WAIT_BAR(0);
#undef DMA_KV
}

__device__ __forceinline__ void sb_unit(const Frame& F, int b, int h, int qb) {
    LAS unsigned char* lds = F.lds + RING_OFF;
    const int lane = F.lane, r32 = lane & 31, hi = lane >> 5, wid = F.wave;
    const int q0 = qb * 256; const size_t rowbase = (size_t)b * SEQ;
    const h16* Qw = F.QO() + (rowbase + q0 + wid * 32) * 1024 + 512 + h * 64;
    const h16* Kh = F.KB() + rowbase * 512 + h * 64; const h16* Vh = F.VB() + rowbase * 512 + h * 64;
    const unsigned lds0 = (unsigned)(uintptr_t)lds;
    LAS unsigned* flag = (LAS unsigned*)(lds + L_FLAG);
    const h16* ksrc = Kh + (size_t)lane * 512 + wid * 8;
    const h16* vsrc = Vh + (size_t)(16 * (wid & 3) + (lane >> 2)) * 512 + (wid >> 2) * 32 + (lane & 3) * 8;
    const unsigned kdst = lds0 + L_K + wid * 1024, vdst = lds0 + L_V + wid * 1024;
#define DMA_KV(t, slot) do { glds16(ksrc + (size_t)(t) * 64 * 512, (unsigned)__builtin_amdgcn_readfirstlane(kdst + (slot))); glds16(vsrc + (size_t)(t) * 64 * 512, (unsigned)__builtin_amdgcn_readfirstlane(vdst + (slot))); } while (0)
    const LAS unsigned char* vp0 = lds + L_V + ((lane >> 4) & 1) * 32 + (lane & 3) * 8 + (4 * hi + ((lane & 15) >> 2)) * 64;
    const int NT = 4 * (qb + 1);
    if (F.tid == 0) flag[0] = 0u;
    DMA_KV(NT - 1, 0);
    hf8 qr[4];
#pragma unroll
    for (int d0 = 0; d0 < 4; ++d0) qr[d0] = __builtin_bit_cast(hf8, *(const u32x4*)(Qw + (size_t)r32 * 1024 + d0 * 16 + hi * 8));
    const int tq = q0 + wid * 32 + r32, tqmax = q0 + wid * 32 + 31;
    float R = 0.f; f32x16 o[2]; o[0] = f32x16{}; o[1] = f32x16{};
    bool done = false; int it = 0;
    for (int t = NT - 1; t >= 0; --t, ++it) {
        const int slot = (it & 1) * SLOTB;
        if (t > 0) { DMA_KV(t - 1, SLOTB - slot); ATT_WAIT_BAR(2); } else { ATT_WAIT_BAR(0); }
        if (!done && 64 * t < tqmax) {
            f32x16 ci = f32x16{}; f32x16 p0, p1; qkt(p0, p1, lds + L_K + slot, qr, ci, r32, hi);
            const bool full = (64 * t + 63 < q0 + wid * 32); (void)full;
            f32x16 s0, s1;
#define SB_FWD(MASKED) _Pragma("unroll") for (int r = 0; r < 16; ++r) { const int key = 64 * t + crow(r, hi); \
                { const float z = fminf(p0[r], 80.f); float sp = __builtin_amdgcn_logf(1.0f + __builtin_amdgcn_exp2f(z)); p0[r] = z - sp; if (MASKED) sp = (key < tq) ? sp : 0.f; s0[r] = sp; } \
                { const float z = fminf(p1[r], 80.f); float sp = __builtin_amdgcn_logf(1.0f + __builtin_amdgcn_exp2f(z)); p1[r] = z - sp; if (MASKED) sp = (key + 32 < tq) ? sp : 0.f; s1[r] = sp; } }
            SB_FWD(true)
#undef SB_FWD
            float T[8], ex[8];
#pragma unroll
            for (int g = 0; g < 8; ++g) { const f32x16& s = (g < 4) ? s0 : s1; const int rb = 4 * (g & 3); const float gsum = (s[rb] + s[rb + 1]) + (s[rb + 2] + s[rb + 3]);
                float slo, shi; half_pair(gsum, slo, shi); T[g] = slo + shi; ex[g] = hi ? 0.f : shi; }
            float suf[8]; suf[7] = 0.f;
#pragma unroll
            for (int g = 6; g >= 0; --g) suf[g] = suf[g + 1] + T[g + 1];
            const float total = suf[0] + T[0];
#define SB_BWD(MASKED) _Pragma("unroll") for (int g = 0; g < 8; ++g) { float run = R + suf[g] + ex[g];     \
                _Pragma("unroll") for (int i = 3; i >= 0; --i) { const int r = 4 * (g & 3) + i; const int key = 64 * t + ((g < 4) ? 0 : 32) + crow(r, hi); \
                    if (g < 4) { float a = __builtin_amdgcn_exp2f(p0[r] - run); if (MASKED) a = (key < tq) ? a : 0.f; p0[r] = a; run += s0[r]; } \
                    else { float a = __builtin_amdgcn_exp2f(p1[r] - run); if (MASKED) a = (key < tq) ? a : 0.f; p1[r] = a; run += s1[r]; } } }
            if (full) { SB_BWD(false) } else { SB_BWD(true) }
#undef SB_BWD
            R += total;
            hf8 pa[4]; pack4(pa, p0, p1);
            pv(o, vp0 + slot, pa);
            if (__all(R > 88.0f)) { done = true; if (lane == 0) __hip_atomic_fetch_add(flag, 1u, __ATOMIC_RELAXED, __HIP_MEMORY_SCOPE_WORKGROUP); }
        }
        ATT_WAIT_BAR(2);
        if (flag[0] >= (unsigned)NWAVES) break;
    }
    asm volatile("s_waitcnt vmcnt(0)" ::: "memory");
    float one[16];
#pragma unroll
    for (int r = 0; r < 16; ++r) one[r] = 1.0f;
    store_o(o, one, const_cast<h16*>(Qw), 1024, F.SS() + (rowbase + q0 + wid * 32) * 16 + 8 + h, lds, wid, lane, r32, hi);
    ATT_WAIT_BAR(0);
#undef DMA_KV
}

__device__ __forceinline__ void dsa_naive_phase(const Frame& F) {
    const int gt = (F.vcu * NWAVES + F.wave) * 64 + F.lane, NT_ = F.G * NWAVES * 64;
    for (int item = gt; item < M * 8; item += NT_) {
        const int h = item & 7, row = item >> 3, b = row / SEQ, t = row % SEQ; const size_t rowbase = (size_t)b * SEQ;
        float q[64], o[64];
        { const h16* qp = F.QO() + (size_t)row * 1024 + h * 64;
#pragma unroll
          for (int c = 0; c < 8; ++c) { const hf8 v = __builtin_bit_cast(hf8, *(const u32x4*)(qp + 8 * c));
#pragma unroll
              for (int e = 0; e < 8; ++e) { q[8 * c + e] = (float)v[e]; o[8 * c + e] = 0.f; } } }
        float m = -1e30f, l = 0.f;
        const unsigned long long* mrow = F.MASK() + (size_t)row * 32;
        for (int s = 0; s <= t; ++s) {
            if (!((mrow[s >> 6] >> (s & 63)) & 1ull)) continue;
            const h16* kp = F.KA() + (rowbase + s) * 512 + h * 64; const h16* vp = F.VA() + (rowbase + s) * 512 + h * 64;
            float dot = 0.f;
#pragma unroll
            for (int c = 0; c < 8; ++c) { const hf8 v = __builtin_bit_cast(hf8, *(const u32x4*)(kp + 8 * c));
#pragma unroll
                for (int e = 0; e < 8; ++e) dot += q[8 * c + e] * (float)v[e]; }
            const float lg = dot + F.rel_bias[t5_bucket(t - s) * 8 + h] * LOG2E;
            if (lg > m) { const float f = __builtin_amdgcn_exp2f(m - lg); l *= f;
#pragma unroll
                for (int d = 0; d < 64; ++d) o[d] *= f;
                m = lg; }
            const float p = __builtin_amdgcn_exp2f(lg - m); l += p;
#pragma unroll
            for (int c = 0; c < 8; ++c) { const hf8 v = __builtin_bit_cast(hf8, *(const u32x4*)(vp + 8 * c));
#pragma unroll
                for (int e = 0; e < 8; ++e) o[8 * c + e] += p * (float)v[e]; }
        }
        const float il = 1.0f / l; h16* op = F.QO() + (size_t)row * 1024 + h * 64;
#pragma unroll
        for (int c = 0; c < 8; ++c) { u32x4 w; w.x = pkh(o[8 * c] * il, o[8 * c + 1] * il); w.y = pkh(o[8 * c + 2] * il, o[8 * c + 3] * il); w.z = pkh(o[8 * c + 4] * il, o[8 * c + 5] * il); w.w = pkh(o[8 * c + 6] * il, o[8 * c + 7] * il);
            *(u32x4*)(op + 8 * c) = w; }
    }
}

__device__ __forceinline__ void sb_naive_phase(const Frame& F) {
    const int gt = (F.vcu * NWAVES + F.wave) * 64 + F.lane, NT_ = F.G * NWAVES * 64;
    for (int item = gt; item < M * 8; item += NT_) {
        const int h = item & 7, row = item >> 3, b = row / SEQ, t = row % SEQ; const size_t rowbase = (size_t)b * SEQ;
        float q[64], o[64];
        { const h16* qp = F.QO() + (size_t)row * 1024 + 512 + h * 64;
#pragma unroll
          for (int c = 0; c < 8; ++c) { const hf8 v = __builtin_bit_cast(hf8, *(const u32x4*)(qp + 8 * c));
#pragma unroll
              for (int e = 0; e < 8; ++e) { q[8 * c + e] = (float)v[e]; o[8 * c + e] = 0.f; } } }
        float R = 0.f;
        for (int s = t - 1; s >= 0 && R < 120.f; --s) {
            const h16* kp = F.KB() + (rowbase + s) * 512 + h * 64; const h16* vp = F.VB() + (rowbase + s) * 512 + h * 64;
            float dot = 0.f;
#pragma unroll
            for (int c = 0; c < 8; ++c) { const hf8 v = __builtin_bit_cast(hf8, *(const u32x4*)(kp + 8 * c));
#pragma unroll
                for (int e = 0; e < 8; ++e) dot += q[8 * c + e] * (float)v[e]; }
            const float z = dot * (1.0f / LOG2E);
            const float sp = fmaxf(z, 0.f) + log1pf(expf(-fabsf(z)));
            const float a = expf((z - sp) - R);
            R += sp;
#pragma unroll
            for (int c = 0; c < 8; ++c) { const hf8 v = __builtin_bit_cast(hf8, *(const u32x4*)(vp + 8 * c));
#pragma unroll
                for (int e = 0; e < 8; ++e) o[8 * c + e] += a * (float)v[e]; }
        }
        h16* op = F.QO() + (size_t)row * 1024 + 512 + h * 64;
#pragma unroll
        for (int c = 0; c < 8; ++c) { u32x4 w; w.x = pkh(o[8 * c], o[8 * c + 1]); w.y = pkh(o[8 * c + 2], o[8 * c + 3]); w.z = pkh(o[8 * c + 4], o[8 * c + 5]); w.w = pkh(o[8 * c + 6], o[8 * c + 7]);
            *(u32x4*)(op + 8 * c) = w; }
    }
}
__device__ __forceinline__ void att_phase(const Frame& F, unsigned long long* ts = nullptr) {
    if (ts && blockIdx.x == 0 && F.tid == 0) ts[19] = __builtin_amdgcn_s_memrealtime();
    for (int i = 0; ; ++i) { const int u = i * F.G + F.vcu; if (u >= 1024) break; const int rnd = u >> 8, c = u & 255, bh = c >> 1, sub = c & 1;
        const int qb = (rnd == 0) ? sub : (rnd == 1) ? 7 - sub : (rnd == 2) ? 2 + sub : 5 - sub;
#if !defined(MK_SKIP_DSA) && !defined(MK_NAIVE_DSA)
        dsa_unit(F, bh >> 3, bh & 7, qb);
#endif
    }
    if (ts && blockIdx.x == 0 && F.tid == 0) ts[20] = __builtin_amdgcn_s_memrealtime();
#ifdef MK_NAIVE_DSA
    dsa_naive_phase(F);
#endif
#ifdef MK_NAIVE_SB
    sb_naive_phase(F);
#endif
    for (int i = 0; ; ++i) { const int u = i * F.G + F.vcu; if (u >= 1024) break; const int rnd = u >> 8, c = u & 255, bh = c >> 1, sub = c & 1;
#if !defined(MK_SKIP_SB) && !defined(MK_NAIVE_SB)
        sb_unit(F, bh >> 3, bh & 7, 4 * sub + rnd);
#endif
    }
}
}

struct Args { const float* in[15]; float* out; unsigned char* ws; int ph_lo, ph_hi, li, pad; };
__global__ void __launch_bounds__(NWAVES * 64, 2) mk_fwd(Args args) {
    extern __shared__ __attribute__((aligned(16))) unsigned char lds_raw[];
    Frame F;
    F.lds = (LAS unsigned char*)lds_raw;
    volatile LAS unsigned* MISC = (volatile LAS unsigned*)(F.lds + MISC_OFF);
    F.tid = threadIdx.x; F.lane = F.tid & 63; F.wave = __builtin_amdgcn_readfirstlane(F.tid >> 6);
    F.G = gridDim.x; { const int bx = blockIdx.x; F.vcu = (F.G % 8 == 0) ? (bx % 8) * (F.G / 8) + bx / 8 : bx; }
    unsigned char* ws = args.ws;
    gu32* ctl = (gu32*)(ws + WS_CTL);
    F.x = args.in[0]; F.c = args.in[1]; F.w_ada = args.in[2]; F.b_ada = args.in[3]; F.g_pre = args.in[4]; F.g_post = args.in[5]; F.w_gate = args.in[6]; F.w_up = args.in[7]; F.w_down = args.in[8];
    F.w_in = args.in[9]; F.g_kidx = args.in[10]; F.rel_bias = args.in[11]; F.g_out_a = args.in[12]; F.g_out_b = args.in[13]; F.w_out = args.in[14]; F.out = args.out;
    F.ws = ws;
    for (int u = F.tid; u < (LDS_BYTES - LDSCTL_OFF) / 4; u += NWAVES * 64) ((LAS unsigned*)(F.lds + LDSCTL_OFF))[u] = 0u;
    __syncthreads();
    XcdBarrier bar; bar.bar = (unsigned*)(ctl + CW_BAR); bar.x = 0; bar.st = nullptr;
    if (N_LAUNCHES == 1) bar = xcd_barrier_post((unsigned*)(ctl + CW_BAR), MISC + 8);
#define GRID_BAR() do { if (N_LAUNCHES == 1) xcd_barrier(bar); } while (0)
    const int lo = args.ph_lo, hi = args.ph_hi;
    unsigned long long* const ts_ = (unsigned long long*)(ctl + 8192);
#define STAMP(k) do { if ((MK_PROF_A >= 0 || MK_PROF_B >= 0) && blockIdx.x == 0 && F.tid == 0) ts_[(k) + 1] = __builtin_amdgcn_s_memrealtime(); } while (0)
    STAMP(-1);
#define IN(k) (lo <= (k) && (k) < hi)
#define SEAM(k) do { if (IN((k) + 1)) GRID_BAR(); } while (0)

    if (IN(0)) { for (int rep_ = 0; rep_ < (MK_REPEAT == 0 ? 2 : 1); ++rep_) { if (rep_) GRID_BAR(); p0_prologue(F); } SEAM(0); STAMP(0); }
    if (IN(1)) { for (int rep_ = 0; rep_ < (MK_REPEAT == 1 ? 2 : 1); ++rep_) { if (rep_) GRID_BAR(); prenorm_phase(F, F.x, 0); } SEAM(1); STAMP(1); }
    if (IN(2)) { _Pragma("unroll") for (int rep_ = 0; rep_ < (MK_REPEAT == 2 ? 2 : 1); ++rep_) { if (rep_) GRID_BAR(); pg8::Gemm g{F.XN(), F.Wgu(0), M, NGU, D}; pg8::StaticOrder S; S.init(M, NGU, F.G, (int)blockIdx.x); pg8::EpiSwiGLU E{F.H()};
        pg8::gemm_phase<pg8::EpiSwiGLU, pg8::StaticOrder>(F.lds + RING_OFF, g, S, E); } SEAM(2); STAMP(2); }
    if (IN(3)) { _Pragma("unroll") for (int rep_ = 0; rep_ < (MK_REPEAT == 3 ? 2 : 1); ++rep_) { if (rep_) GRID_BAR(); pg8::Gemm g{F.H(), F.Wd(0), M, D, FF}; pg8::StaticOrder S; S.init(M, D, F.G, (int)blockIdx.x); pg8::EpiF16 E{F.Fb(), D};
        pg8::gemm_phase<pg8::EpiF16, pg8::StaticOrder>(F.lds + RING_OFF, g, S, E); } SEAM(3); STAMP(3); }
    if (IN(4)) { for (int rep_ = 0; rep_ < (MK_REPEAT == 4 ? 2 : 1); ++rep_) { if (rep_) GRID_BAR(); resnorm_phase<true, false>(F, 0, 0.5f, 1); } SEAM(4); STAMP(4); }
    if (IN(5)) { _Pragma("unroll") for (int rep_ = 0; rep_ < (MK_REPEAT == 5 ? 2 : 1); ++rep_) { if (rep_) GRID_BAR(); pg8::Gemm g{F.XN(), F.Win(), M, NINP, D}; pg8::StaticOrder S; S.init(M, NINP, F.G, (int)blockIdx.x); pg8::EpiInProj E{F.QO(), F.KA(), F.VA(), F.QI(), F.KB(), F.VB(), F.KI(), F.WI(), F.g_kidx};
        pg8::gemm_phase<pg8::EpiInProj, pg8::StaticOrder>(F.lds + RING_OFF, g, S, E); } SEAM(5); STAMP(5); }
#ifdef MK_NAIVE_IDX
    if (IN(6)) { for (int rep_ = 0; rep_ < (MK_REPEAT == 6 ? 2 : 1); ++rep_) { if (rep_) GRID_BAR(); idx_naive_phase(F); } SEAM(6); STAMP(6); }
#else
    if (IN(6)) { for (int rep_ = 0; rep_ < (MK_REPEAT == 6 ? 2 : 1); ++rep_) { if (rep_) GRID_BAR(); idx_phase(F); } SEAM(6); STAMP(6); }
#endif
    if (IN(7)) { for (int rep_ = 0; rep_ < (MK_REPEAT == 7 ? 2 : 1); ++rep_) { if (rep_) GRID_BAR(); att::att_phase(F, (MK_PROF_A >= 0 || MK_PROF_B >= 0) ? ts_ : nullptr); } if (IN(9)) GRID_BAR(); STAMP(7); STAMP(8); }
    if (IN(9)) { _Pragma("unroll") for (int rep_ = 0; rep_ < (MK_REPEAT == 9 ? 2 : 1); ++rep_) { if (rep_) GRID_BAR(); pg8::Gemm g{F.QO(), F.Wout(), M, D, D}; pg8::StaticOrder S; S.init(M, D, F.G, (int)blockIdx.x); pg8::EpiOutProj E{F.Fb(), F.SS()};
        pg8::gemm_phase<pg8::EpiOutProj, pg8::StaticOrder>(F.lds + RING_OFF, g, S, E); } SEAM(9); STAMP(9); }
    if (IN(10)) { for (int rep_ = 0; rep_ < (MK_REPEAT == 10 ? 2 : 1); ++rep_) { if (rep_) GRID_BAR(); resnorm_phase<false, false>(F, 1, 1.0f, 2); } SEAM(10); STAMP(10); }
    if (IN(11)) { _Pragma("unroll") for (int rep_ = 0; rep_ < (MK_REPEAT == 11 ? 2 : 1); ++rep_) { if (rep_) GRID_BAR(); pg8::Gemm g{F.XN(), F.Wgu(1), M, NGU, D}; pg8::StaticOrder S; S.init(M, NGU, F.G, (int)blockIdx.x); pg8::EpiSwiGLU E{F.H()};
        pg8::gemm_phase<pg8::EpiSwiGLU, pg8::StaticOrder>(F.lds + RING_OFF, g, S, E); } SEAM(11); STAMP(11); }
    if (IN(12)) { _Pragma("unroll") for (int rep_ = 0; rep_ < (MK_REPEAT == 12 ? 2 : 1); ++rep_) { if (rep_) GRID_BAR(); pg8::Gemm g{F.H(), F.Wd(1), M, D, FF}; pg8::StaticOrder S; S.init(M, D, F.G, (int)blockIdx.x); pg8::EpiF16 E{F.Fb(), D};
        pg8::gemm_phase<pg8::EpiF16, pg8::StaticOrder>(F.lds + RING_OFF, g, S, E); } SEAM(12); STAMP(12); }
    if (IN(13)) { resnorm_phase<false, true>(F, 2, 0.5f, -1, (MK_PROF_A >= 0 || MK_PROF_B >= 0) ? ts_ : nullptr); }
#undef IN
#undef SEAM
#undef GRID_BAR
}

extern "C" void kernel_launch(void* const* d_in, const int* in_sizes, int n_in, void* d_out, int out_size, void* d_ws, size_t ws_size, hipStream_t stream) {
    static int grid = 0;
    if (grid == 0) {
        if (n_in != 15 || in_sizes[0] != M * D || out_size != M * D || ws_size < WS_END) { fprintf(stderr, "kernel_launch: unexpected shapes (n_in %d, in0 %d, out %d, ws %zu); nothing launched\n", n_in, n_in > 0 ? in_sizes[0] : -1, out_size, ws_size); grid = -1; return; }
        int dev = 0, cus = 0, per_cu = 0;
        if (hipGetDevice(&dev) != hipSuccess || hipDeviceGetAttribute(&cus, hipDeviceAttributeMultiprocessorCount, dev) != hipSuccess) { grid = -1; return; }
        if (hipFuncSetAttribute((const void*)mk_fwd, hipFuncAttributeMaxDynamicSharedMemorySize, LDS_BYTES) != hipSuccess) { fprintf(stderr, "kernel_launch: hipFuncSetAttribute failed\n"); grid = -1; return; }
        if (hipOccupancyMaxActiveBlocksPerMultiprocessor(&per_cu, (const void*)mk_fwd, NWAVES * 64, LDS_BYTES) != hipSuccess || per_cu < 1) fprintf(stderr, "kernel_launch: occupancy query reports %d\n", per_cu);
        (void)hipGetLastError();
        grid = cus;
    }
    if (grid < 0) return;
    if (hipMemsetAsync((char*)d_ws + WS_CTL, 0, CTL_ZERO_BYTES, stream) != hipSuccess) return;
    Args a{};
    for (int i = 0; i < 15; ++i) a.in[i] = (const float*)d_in[i];
    a.out = (float*)d_out; a.ws = (unsigned char*)d_ws;
    for (int li = 0; li < N_LAUNCHES; ++li) {
        a.ph_lo = (N_LAUNCHES == 1) ? 0 : li; a.ph_hi = (N_LAUNCHES == 1) ? NPHASE : li + 1; a.li = li;
        if (li > MK_DEBUG_STOP) { a.ph_lo = MK_DEBUG_MODE; a.ph_hi = MK_DEBUG_MODE + 1; }
        hipLaunchKernelGGL(mk_fwd, dim3(grid), dim3(NWAVES * 64), LDS_BYTES, stream, a);
        if (li > MK_DEBUG_STOP) break;
    }
}
```

```cpp
#include <hip/hip_runtime.h>
#include <cstdio>
#include <cstdint>
#include <cmath>

#define LAS __attribute__((address_space(3)))
#define GAS __attribute__((address_space(1)))
typedef unsigned short h16;
typedef _Float16 hf8 __attribute__((ext_vector_type(8)));
typedef _Float16 hf2 __attribute__((ext_vector_type(2)));
typedef float f32x2 __attribute__((ext_vector_type(2)));
typedef float f32x4 __attribute__((ext_vector_type(4)));
typedef float f32x16 __attribute__((ext_vector_type(16)));
typedef unsigned u32x2 __attribute__((ext_vector_type(2)));
typedef unsigned u32x4 __attribute__((ext_vector_type(4)));
typedef short s16x4 __attribute__((ext_vector_type(4)));
typedef short v4i16_t __attribute__((ext_vector_type(4)));

__device__ __forceinline__ unsigned pkh(float lo, float hi) { f32x2 v = {lo, hi}; hf2 h = __builtin_convertvector(v, hf2); return __builtin_bit_cast(unsigned, h); }

constexpr int NB = 16, SEQ = 2048, M = NB * SEQ, D = 1024, FF = 2816, NGU = 2 * FF, NINP = 3840, INCOLS = 3656, NMOD = 9 * D;
constexpr float EPS = 1e-6f;
constexpr float LOG2E = 1.4426950408889634f;
constexpr float C2 = 0.125f * LOG2E;

namespace pg8 {
constexpr int BM = 256, BK = 64, HALF = 128, HTB = HALF * BK * 2, STAGE_BYTES = 8 * HTB, NXCD = 8, WGM = 8;
__host__ __device__ __forceinline__ int lds_byte(int r, int c) { const int st = (r >> 4) * 2 + (c >> 5), rr = r & 15, cc = c & 31, ob = rr * 64 + cc * 2; return st * 1024 + (ob ^ (((ob >> 9) & 1) << 5)); }
__host__ __device__ __forceinline__ void stage_rc(int b, int& R, int& C) { const int st = b / 1024, sb = b % 1024, swz = sb ^ (((sb >> 9) & 1) << 5); R = (st >> 1) * 16 + swz / 64; C = (st & 1) * 32 + (swz % 64) / 2; }
__host__ __device__ __forceinline__ int perm32(int rho) { const int n = rho >> 4, i = rho & 15; return 8 * (i >> 2) + 4 * n + (i & 3); }
struct Unit { int pm, pn, par; };
struct Gemm { const h16* A; const h16* Bt; int M, N, K; };
struct StaticOrder {
    int nM, nN, nwg, G, c;
    __host__ __device__ void init(int M_, int N_, int G_, int c_) { nM = M_ / BM; nN = N_ / BM; nwg = nM * nN; G = G_; c = c_; }
    __host__ __device__ bool next(int i, Unit& u) const {
        const long L = (long)i * G + c; if (L >= nwg) return false;
        int wgid = (int)L; { const int q = nwg / NXCD, r = nwg % NXCD, xcd = wgid % NXCD, off = wgid / NXCD; wgid = (xcd < r ? xcd * (q + 1) : r * (q + 1) + (xcd - r) * q) + off; }
        const int nig = WGM * nN, gid = wgid / nig, fm = gid * WGM, gsz = (nM - fm) < WGM ? (nM - fm) : WGM;
        u.pm = fm + ((wgid % nig) % gsz); u.pn = (wgid % nig) / gsz; u.par = i & 1; return true;
    }
    __device__ __forceinline__ void a_ready(const Unit&) const {}
    __device__ __forceinline__ void done(const Unit&) const {}
};
__device__ __forceinline__ float silu_mul(float g, float u) { const float e = __builtin_amdgcn_exp2f(-g * LOG2E); return g * u * __builtin_amdgcn_rcpf(1.0f + e); }
struct EpiSwiGLU {
    static constexpr bool HAS_MID = false;
    static constexpr bool PERM = true;
    h16* H;
    __device__ __forceinline__ void operator()(const f32x4 (&acc)[2][2][4][2], const Unit& u, int wr, int wc, int fr, int fq) const {
        const int row0 = u.pm * BM + wr * 64 + fr, col0 = u.pn * HALF + wc * 32 + 8 * fq;
#pragma unroll
        for (int ai = 0; ai < 2; ++ai)
#pragma unroll
            for (int m = 0; m < 4; ++m) {
                const f32x4 g0 = acc[ai][0][m][0], g1 = acc[ai][0][m][1], u0 = acc[ai][1][m][0], u1 = acc[ai][1][m][1];
                u32x4 w; w.x = pkh(silu_mul(g0[0], u0[0]), silu_mul(g0[1], u0[1])); w.y = pkh(silu_mul(g0[2], u0[2]), silu_mul(g0[3], u0[3]));
                w.z = pkh(silu_mul(g1[0], u1[0]), silu_mul(g1[1], u1[1])); w.w = pkh(silu_mul(g1[2], u1[2]), silu_mul(g1[3], u1[3]));
                *(u32x4*)(H + (size_t)(row0 + ai * HALF + m * 16) * FF + col0) = w; }
    }
};
struct EpiF32 {
    static constexpr bool HAS_MID = false;
    static constexpr bool PERM = false;
    float* O; int ldc;
    __device__ __forceinline__ void operator()(const f32x4 (&acc)[2][2][4][2], const Unit& u, int wr, int wc, int fr, int fq) const {
        const int row0 = u.pm * BM + wr * 64 + fr, col0 = u.pn * BM + wc * 32 + 4 * fq;
#pragma unroll
        for (int ai = 0; ai < 2; ++ai)
#pragma unroll
            for (int m = 0; m < 4; ++m) { float* rowp = O + (size_t)(row0 + ai * HALF + m * 16) * ldc + col0;
#pragma unroll
                for (int bj = 0; bj < 2; ++bj)
#pragma unroll
                    for (int n = 0; n < 2; ++n) *(f32x4*)(rowp + bj * HALF + n * 16) = acc[ai][bj][m][n]; }
    }
};
struct EpiF16 {
    static constexpr bool HAS_MID = false;
    static constexpr bool PERM = true;
    h16* O; int ldc;
    __device__ __forceinline__ void operator()(const f32x4 (&acc)[2][2][4][2], const Unit& u, int wr, int wc, int fr, int fq) const {
        const int row0 = u.pm * BM + wr * 64 + fr, col0 = u.pn * BM + wc * 32 + 8 * fq;
#pragma unroll
        for (int ai = 0; ai < 2; ++ai)
#pragma unroll
            for (int m = 0; m < 4; ++m) { h16* rowp = O + (size_t)(row0 + ai * HALF + m * 16) * ldc + col0;
#pragma unroll
                for (int bj = 0; bj < 2; ++bj) { const f32x4 v0 = acc[ai][bj][m][0], v1 = acc[ai][bj][m][1];
                    u32x4 w; w.x = pkh(v0[0], v0[1]); w.y = pkh(v0[2], v0[3]); w.z = pkh(v1[0], v1[1]); w.w = pkh(v1[2], v1[3]);
                    *(u32x4*)(rowp + bj * HALF) = w; } }
    }
};
constexpr int TAB_OFF = STAGE_BYTES;
struct EpiOutProj {
    static constexpr bool PERM = true, HAS_MID = true;
    h16* O; const float* SS;
    __device__ __forceinline__ void begin(const Unit& u, LAS unsigned char* lds, int tid) const {
        if (tid < 256) { const f32x4* p = (const f32x4*)(SS + (size_t)(u.pm * BM + tid) * 16); const f32x4 a0 = p[0], a1 = p[1], b0 = p[2], b1 = p[3];
            const float sa = ((a0[0] + a0[1]) + (a0[2] + a0[3])) + ((a1[0] + a1[1]) + (a1[2] + a1[3])), sb = ((b0[0] + b0[1]) + (b0[2] + b0[3])) + ((b1[0] + b1[1]) + (b1[2] + b1[3]));
            const float ra = 1.0f / sqrtf(sa * (1.0f / 512.0f) + EPS), rb = 1.0f / sqrtf(sb * (1.0f / 512.0f) + EPS);
            *(LAS f32x2*)(lds + TAB_OFF + u.par * 2048 + tid * 8) = (f32x2){ra / rb, rb}; }
    }
    __device__ __forceinline__ void mid(f32x4 (&acc)[2][2][4][2], const Unit& u, LAS unsigned char* lds, int wr, int fr) const {
        const LAS unsigned char* tb = lds + TAB_OFF + u.par * 2048 + (wr * 64 + fr) * 8;
#pragma unroll
        for (int ai = 0; ai < 2; ++ai)
#pragma unroll
            for (int m = 0; m < 4; ++m) { const float s = *(const LAS float*)(tb + (ai * HALF + m * 16) * 8);
#pragma unroll
                for (int bj = 0; bj < 2; ++bj)
#pragma unroll
                    for (int n = 0; n < 2; ++n) acc[ai][bj][m][n] *= s; }
    }
    __device__ __forceinline__ void fin(const f32x4 (&acc)[2][2][4][2], const Unit& u, LAS unsigned char* lds, int wr, int wc, int fr, int fq) const {
        const int row0 = u.pm * BM + wr * 64 + fr, col0 = u.pn * BM + wc * 32 + 8 * fq; const LAS unsigned char* tb = lds + TAB_OFF + u.par * 2048 + (wr * 64 + fr) * 8 + 4;
#pragma unroll
        for (int ai = 0; ai < 2; ++ai)
#pragma unroll
            for (int m = 0; m < 4; ++m) { const float rb = *(const LAS float*)(tb + (ai * HALF + m * 16) * 8); h16* rowp = O + (size_t)(row0 + ai * HALF + m * 16) * D + col0;
#pragma unroll
                for (int bj = 0; bj < 2; ++bj) { const f32x4 v0 = acc[ai][bj][m][0] * rb, v1 = acc[ai][bj][m][1] * rb;
                    u32x4 w; w.x = pkh(v0[0], v0[1]); w.y = pkh(v0[2], v0[3]); w.z = pkh(v1[0], v1[1]); w.w = pkh(v1[2], v1[3]);
                    *(u32x4*)(rowp + bj * HALF) = w; } }
    }
    __device__ __forceinline__ void operator()(const f32x4 (&)[2][2][4][2], const Unit&, int, int, int, int) const {}
};
struct EpiInProj {
    static constexpr bool HAS_MID = false;
    static constexpr bool PERM = true;
    h16 *QO, *KA, *VA, *QI, *KB, *VB, *KI; float* WI; const float* gk;
    __device__ __forceinline__ void operator()(const f32x4 (&acc)[2][2][4][2], const Unit& u, int wr, int wc, int fr, int fq) const {
        const int row0 = u.pm * BM + wr * 64 + fr;
        if (u.pn < 14) {
            const int sel = u.pn >> 1; h16* base; int ld = 512, coff = (u.pn & 1) * 256; float sc = 1.0f;
            if (sel == 0) { base = QO; ld = 1024; sc = C2; } else if (sel == 1) { base = QO; ld = 1024; coff += 512; sc = C2; }
            else if (sel == 2) base = KA; else if (sel == 3) base = VA; else if (sel == 4) base = QI; else if (sel == 5) base = KB; else base = VB;
            const int col0 = coff + wc * 32 + 8 * fq;
#pragma unroll
            for (int ai = 0; ai < 2; ++ai)
#pragma unroll
                for (int m = 0; m < 4; ++m) { h16* rowp = base + (size_t)(row0 + ai * HALF + m * 16) * ld + col0;
#pragma unroll
                    for (int bj = 0; bj < 2; ++bj) { const f32x4 v0 = acc[ai][bj][m][0] * sc, v1 = acc[ai][bj][m][1] * sc;
                        u32x4 w; w.x = pkh(v0[0], v0[1]); w.y = pkh(v0[2], v0[3]); w.z = pkh(v1[0], v1[1]); w.w = pkh(v1[2], v1[3]);
                        *(u32x4*)(rowp + bj * HALF) = w; } }
        } else if (wc == 0) {
            f32x4 g[2][2];
#pragma unroll
            for (int bj = 0; bj < 2; ++bj)
#pragma unroll
                for (int n = 0; n < 2; ++n) g[bj][n] = *(const f32x4*)(gk + bj * 32 + 8 * fq + 4 * n);
#pragma unroll
            for (int ai = 0; ai < 2; ++ai)
#pragma unroll
                for (int m = 0; m < 4; ++m) { float ss = 0.f;
#pragma unroll
                    for (int bj = 0; bj < 2; ++bj)
#pragma unroll
                        for (int n = 0; n < 2; ++n) { const f32x4 x = acc[ai][bj][m][n]; ss += (x[0] * x[0] + x[1] * x[1]) + (x[2] * x[2] + x[3] * x[3]); }
                    ss += __shfl_xor(ss, 16); ss += __shfl_xor(ss, 32);
                    const float rstd = 1.0f / sqrtf(ss * (1.0f / 64.0f) + EPS);
                    h16* rowp = KI + (size_t)(row0 + ai * HALF + m * 16) * 64 + 8 * fq;
#pragma unroll
                    for (int bj = 0; bj < 2; ++bj) { const f32x4 v0 = acc[ai][bj][m][0] * rstd * g[bj][0], v1 = acc[ai][bj][m][1] * rstd * g[bj][1];
                        u32x4 w; w.x = pkh(v0[0], v0[1]); w.y = pkh(v0[2], v0[3]); w.z = pkh(v1[0], v1[1]); w.w = pkh(v1[2], v1[3]);
                        *(u32x4*)(rowp + bj * 32) = w; } }
        } else if (wc == 1 && fq == 0) {
            const float ws = 0.044194173824159216f;
#pragma unroll
            for (int ai = 0; ai < 2; ++ai)
#pragma unroll
                for (int m = 0; m < 4; ++m) { float* rowp = WI + (size_t)(row0 + ai * HALF + m * 16) * 8;
                    *(f32x4*)rowp = acc[ai][0][m][0] * ws; *(f32x4*)(rowp + 4) = acc[ai][0][m][1] * ws; }
        }
    }
};

template <class Epi, class Sched>
__device__ __forceinline__ void gemm_phase(LAS unsigned char* lds, const Gemm g, const Sched& S, const Epi& E) {
    const int tid = threadIdx.x, wid = __builtin_amdgcn_readfirstlane(tid >> 6), lane = tid & 63, wr = wid >> 2, wc = wid & 3, fr = lane & 15, fq = lane >> 4;
    const int K = g.K, nt = K / BK;
    unsigned voffA[2], voffB[2];
#pragma unroll
    for (int i = 0; i < 2; ++i) { int R, C; stage_rc(tid * 16 + i * 8192, R, C); const int Rb = Epi::PERM ? ((R & ~31) + perm32(R & 31)) : R;
        voffA[i] = (unsigned)(R * K + C) * 2u; voffB[i] = (unsigned)(Rb * K + C) * 2u; }
    const size_t kstep = (size_t)(BK * 2);
    const size_t hstep = (size_t)HALF * K * 2;
    const size_t tstep = 2 * hstep;
    const unsigned ldsw = (unsigned)wid * 1024u;
    const int aoff = lds_byte(wr * 64 + fr, fq * 8), boff = lds_byte(wc * 32 + fr, fq * 8);
#define PG8_SA(b, h) (((b) * 2 + (h)) * HTB)
#define PG8_SB(b, h) ((4 + (b) * 2 + (h)) * HTB)
#define PG8_STAGE(bufoff, gbase, voff) do { _Pragma("unroll") for (int _i = 0; _i < 2; ++_i) \
        __builtin_amdgcn_global_load_lds((const unsigned*)((const char*)(gbase) + (voff)[_i]), (LAS unsigned*)(lds + (bufoff) + ldsw + _i * 8192), 16, 0, 0); } while (0)
#define PG8_LDA(dst, b, h) do { _Pragma("unroll") for (int m = 0; m < 4; ++m) _Pragma("unroll") for (int k = 0; k < 2; ++k) dst[m][k] = *(const LAS hf8*)(lds + PG8_SA(b, h) + aoff + m * 2048 + k * 1024); } while (0)
#define PG8_LDB(dst, b, h) do { _Pragma("unroll") for (int n = 0; n < 2; ++n) _Pragma("unroll") for (int k = 0; k < 2; ++k) dst[n][k] = *(const LAS hf8*)(lds + PG8_SB(b, h) + boff + n * 2048 + k * 1024); } while (0)
#define PG8_MMA(ai, bj, At, Bt) do { __builtin_amdgcn_s_setprio(1); _Pragma("unroll") for (int m = 0; m < 4; ++m) _Pragma("unroll") for (int n = 0; n < 2; ++n) _Pragma("unroll") for (int k = 0; k < 2; ++k) \
        acc[ai][bj][m][n] = __builtin_amdgcn_mfma_f32_16x16x32_f16(Bt[n][k], At[m][k], acc[ai][bj][m][n], 0, 0, 0); __builtin_amdgcn_s_setprio(0); } while (0)
#define PG8_WAIT_V(n) asm volatile("s_waitcnt vmcnt(" #n ")" ::: "memory")
#define PG8_WAIT_L(n) asm volatile("s_waitcnt lgkmcnt(" #n ")" ::: "memory")
#define PG8_BAR __builtin_amdgcn_s_barrier()
#define PG8_SCHED __builtin_amdgcn_sched_barrier(0)
    Unit cur, nxt; int ui = 0;
    if (!S.next(0, cur)) return;
    f32x4 acc[2][2][4][2];
#pragma unroll
    for (int a = 0; a < 2; ++a)
#pragma unroll
        for (int b = 0; b < 2; ++b)
#pragma unroll
            for (int m = 0; m < 4; ++m)
#pragma unroll
                for (int n = 0; n < 2; ++n) acc[a][b][m][n] = (f32x4){0.f, 0.f, 0.f, 0.f};
    hf8 At[4][2], B0[2][2], B1[2][2];
    const char* cA = (const char*)g.A + (size_t)cur.pm * tstep; const char* cB = (const char*)g.Bt + (size_t)cur.pn * tstep;
    S.a_ready(cur);
    if constexpr (Epi::HAS_MID) E.begin(cur, lds, tid);
    PG8_STAGE(PG8_SB(0, 0), cB, voffB); PG8_STAGE(PG8_SB(0, 1), cB + hstep, voffB); PG8_STAGE(PG8_SA(0, 0), cA, voffA); PG8_STAGE(PG8_SA(0, 1), cA + hstep, voffA);
    if (wr == 1) PG8_BAR;
    PG8_WAIT_V(2); PG8_BAR;
    PG8_STAGE(PG8_SB(1, 0), cB + kstep, voffB); PG8_STAGE(PG8_SA(1, 0), cA + kstep, voffA); PG8_STAGE(PG8_SB(1, 1), cB + hstep + kstep, voffB);
    PG8_WAIT_V(6); PG8_BAR;
    for (;;) {
        const bool has_next = S.next(ui + 1, nxt);
        const char* nA = has_next ? (const char*)g.A + (size_t)nxt.pm * tstep : cA; const char* nB = has_next ? (const char*)g.Bt + (size_t)nxt.pn * tstep : cB;
        for (int t = 0; t < nt; t += 2) {
            const bool last = (t == nt - 2);
            const char* a1 = cA + (size_t)(t + 1) * kstep;
            const char* a2 = last ? nA : cA + (size_t)(t + 2) * kstep; const char* b2 = last ? nB : cB + (size_t)(t + 2) * kstep;
            const char* a3 = a2 + kstep; const char* b3 = b2 + kstep;
            if (last && has_next) S.a_ready(nxt);
            if constexpr (Epi::HAS_MID) { if (t == (nt >> 1)) E.mid(acc, cur, lds, wr, fr); }
            PG8_LDB(B0, 0, 0); PG8_LDB(B1, 0, 1); PG8_SCHED; PG8_LDA(At, 0, 0); PG8_STAGE(PG8_SA(1, 1), a1 + hstep, voffA);
            PG8_WAIT_V(8); PG8_WAIT_L(0); PG8_BAR; PG8_MMA(0, 0, At, B0); PG8_MMA(0, 1, At, B1); PG8_BAR; PG8_SCHED;
            PG8_LDA(At, 0, 1); PG8_STAGE(PG8_SB(0, 0), b2, voffB); PG8_STAGE(PG8_SB(0, 1), b2 + hstep, voffB); PG8_STAGE(PG8_SA(0, 0), a2, voffA);
            PG8_WAIT_V(8); PG8_WAIT_L(0); PG8_BAR; PG8_MMA(1, 0, At, B0); PG8_MMA(1, 1, At, B1); PG8_BAR; PG8_SCHED;
            PG8_LDB(B0, 1, 0); PG8_LDB(B1, 1, 1); PG8_SCHED; PG8_LDA(At, 1, 0); PG8_STAGE(PG8_SA(0, 1), a2 + hstep, voffA);
            PG8_WAIT_V(8); PG8_WAIT_L(0); PG8_BAR; PG8_MMA(0, 0, At, B0); PG8_MMA(0, 1, At, B1); PG8_BAR; PG8_SCHED;
            PG8_LDA(At, 1, 1); PG8_STAGE(PG8_SB(1, 0), b3, voffB); PG8_STAGE(PG8_SB(1, 1), b3 + hstep, voffB); PG8_STAGE(PG8_SA(1, 0), a3, voffA);
            PG8_WAIT_V(8); PG8_WAIT_L(0); PG8_BAR; PG8_MMA(1, 0, At, B0); PG8_MMA(1, 1, At, B1); PG8_BAR; PG8_SCHED;
        }
        if (wr == 0) PG8_BAR;
        if constexpr (Epi::HAS_MID) E.fin(acc, cur, lds, wr, wc, fr, fq); else E(acc, cur, wr, wc, fr, fq);
        S.done(cur);
        if (!has_next) break;
#pragma unroll
        for (int a = 0; a < 2; ++a)
#pragma unroll
            for (int b = 0; b < 2; ++b)
#pragma unroll
                for (int m = 0; m < 4; ++m)
#pragma unroll
                    for (int n = 0; n < 2; ++n) acc[a][b][m][n] = (f32x4){0.f, 0.f, 0.f, 0.f};
        cur = nxt; cA = nA; cB = nB; ++ui;
        if constexpr (Epi::HAS_MID) E.begin(cur, lds, tid);
        if (wr == 1) PG8_BAR;
    }
    PG8_WAIT_V(0);
    PG8_BAR;
#undef PG8_SA
#undef PG8_SB
#undef PG8_STAGE
#undef PG8_LDA
#undef PG8_LDB
#undef PG8_MMA
#undef PG8_WAIT_V
#undef PG8_WAIT_L
#undef PG8_BAR
#undef PG8_SCHED
}
}

constexpr int NWAVES = 8;
constexpr int NPHASE = 14;
#ifndef MK_N_LAUNCHES
#define MK_N_LAUNCHES 1
#endif
constexpr int N_LAUNCHES = MK_N_LAUNCHES;
#ifndef MK_PROF_A
#define MK_PROF_A -1
#endif
#ifndef MK_PROF_B
#define MK_PROF_B -1
#endif
#ifndef MK_REPEAT
#define MK_REPEAT -1
#endif
#ifndef MK_DEBUG_STOP
#define MK_DEBUG_STOP 99
#endif
#ifndef MK_DEBUG_MODE
#define MK_DEBUG_MODE 100
#endif

constexpr size_t MiB = 1u << 20;
constexpr size_t WS_CTL = 0, CTL_ZERO_BYTES = 1 * MiB;
constexpr size_t WS_MODS = 1 * MiB;
constexpr size_t WS_WGU1 = 2 * MiB, WS_WGU2 = 13 * MiB, WS_WD1 = 24 * MiB, WS_WD2 = 30 * MiB, WS_WIN = 36 * MiB, WS_WOUT = 44 * MiB;
constexpr size_t WS_XN = 48 * MiB;
constexpr size_t WS_H = 112 * MiB;
constexpr size_t WS_QO = 112 * MiB, WS_KA = 176 * MiB, WS_VA = 208 * MiB, WS_QI = 240 * MiB, WS_KI = 272 * MiB, WS_WI = 276 * MiB, WS_MASK = 277 * MiB;
constexpr size_t WS_SS = 285 * MiB;
constexpr size_t WS_H1 = 288 * MiB;
constexpr size_t WS_F = 416 * MiB;
constexpr size_t WS_KB = 416 * MiB, WS_VB = 448 * MiB, WS_END = 480 * MiB;
static_assert(WS_H + (size_t)M * FF * 2 <= WS_H1 && WS_MASK + (size_t)M * 256 <= WS_H1 && WS_WOUT + (size_t)D * D * 2 <= WS_XN, "d_ws map");
constexpr int CW_TMO = 0, CW_BAR = 4096;

constexpr int RING_OFF = 0, RING_BYTES = 135168;
constexpr int LDSCTL_OFF = RING_BYTES, MISC_OFF = LDSCTL_OFF + 320;
constexpr int LDS_BYTES = 147456;

typedef GAS unsigned gu32;
#define RLX_AGENT __ATOMIC_RELAXED, __HIP_MEMORY_SCOPE_AGENT
#define LDS_WAIT() asm volatile("s_waitcnt lgkmcnt(0)" ::: "memory")
#define VM_WAIT() asm volatile("s_waitcnt vmcnt(0)" ::: "memory")

#define XB_TMO      128
#define XB_XCNT(j)  (256  + 64 * (j))
#define XB_XSUB(j)  (1280 + 64 * (j))
#define XB_XGEN(j)  (2304 + 64 * (j))
#define XB_TOP      3328
#define XB_TOPGEN   3392
#define XCD_BAR_WORDS 3456
#define XB_SPIN_CAP (1u << 18)
__device__ __forceinline__ unsigned xb_ld(unsigned* p)              { return __hip_atomic_load(p, __ATOMIC_RELAXED, __HIP_MEMORY_SCOPE_AGENT); }
__device__ __forceinline__ unsigned xb_add(unsigned* p, unsigned v) { return __hip_atomic_fetch_add(p, v, __ATOMIC_RELAXED, __HIP_MEMORY_SCOPE_AGENT); }
__device__ __forceinline__ unsigned xb_xcc_id() { return (unsigned)__builtin_amdgcn_s_getreg((3 << 11) | 20) & 0xFu; }
#define XB_SPIN(cond, bar) do { unsigned _sp = 0; while (cond) { __builtin_amdgcn_s_sleep(1); \
    if ((++_sp & 255u) == 0u) { if (xb_ld(&(bar)[XB_TMO])) break; if (_sp > XB_SPIN_CAP) { atomicAdd(&(bar)[XB_TMO], 1u); break; } } } } while (0)
struct XcdBarrier { unsigned* bar; unsigned x; volatile LAS unsigned* st; };
__device__ __forceinline__ XcdBarrier xcd_barrier_post(unsigned* bar, volatile LAS unsigned* st) {
    XcdBarrier b; b.bar = bar; b.x = xb_xcc_id(); b.st = st;
    if (threadIdx.x == 0) (void)xb_add(&bar[XB_XCNT(b.x)], 1u);
    return b;
}
__device__ __forceinline__ void xcd_barrier_complete(unsigned* bar, unsigned x, unsigned& nloc, unsigned& nx) {
    const unsigned G = gridDim.x * gridDim.y * gridDim.z;
    unsigned sum, cnt, mine, sp = 0u;
    for (;;) {
        sum = 0u; cnt = 0u; mine = 0u;
#pragma unroll
        for (unsigned j = 0; j < 16; ++j) { const unsigned c = xb_ld(&bar[XB_XCNT(j)]); sum += c; cnt += (c > 0u) ? 1u : 0u; mine = (j == x) ? c : mine; }
        if (sum == G) break;
        __builtin_amdgcn_s_sleep(1);
        if ((++sp & 255u) == 0u) { if (xb_ld(&bar[XB_TMO])) break; if (sp > XB_SPIN_CAP) { atomicAdd(&bar[XB_TMO], 1u); break; } }
    }
    nloc = mine > 0u ? mine : 1u; nx = cnt > 0u ? cnt : 1u;
}
__device__ __forceinline__ void xcd_barrier(const XcdBarrier& b) {
    asm volatile("s_waitcnt vmcnt(0)" ::: "memory");
    __syncthreads();
    if (threadIdx.x == 0) {
        unsigned* bar = b.bar;
        __builtin_amdgcn_s_waitcnt(0);
        unsigned nloc = b.st[0], nx = b.st[1];
        if (nloc == 0u) { xcd_barrier_complete(bar, b.x, nloc, nx); b.st[0] = nloc; b.st[1] = nx; }
        const unsigned old = xb_add(&bar[XB_XSUB(b.x)], 1u);
        const unsigned gen = old / nloc;
        if (old + 1u == (gen + 1u) * nloc) {
            __builtin_amdgcn_fence(__ATOMIC_RELEASE, "agent");
            asm volatile("s_waitcnt vmcnt(0)" ::: "memory");
            const unsigned og = xb_add(&bar[XB_TOP], 1u);
            const unsigned tg = og / nx;
            if (og + 1u == (tg + 1u) * nx) xb_add(&bar[XB_TOPGEN], 1u);
            else XB_SPIN(xb_ld(&bar[XB_TOPGEN]) == tg, bar);
            __builtin_amdgcn_fence(__ATOMIC_ACQUIRE, "agent");
            xb_add(&bar[XB_XGEN(b.x)], 1u);
            asm volatile("s_waitcnt vmcnt(0)" ::: "memory");
        } else {
            XB_SPIN(xb_ld(&bar[XB_XGEN(b.x)]) == gen, bar);
            __builtin_amdgcn_fence(__ATOMIC_ACQUIRE, "agent");
            asm volatile("s_waitcnt vmcnt(0)" ::: "memory");
        }
    }
    __syncthreads();
}

struct Frame {
    LAS unsigned char* lds;
    int tid, lane, wave, vcu, G;
    const float *x, *c, *w_ada, *b_ada, *g_pre, *g_post, *w_gate, *w_up, *w_down, *w_in, *g_kidx, *rel_bias, *g_out_a, *g_out_b, *w_out;
    float* out;
    unsigned char* ws;
    __device__ __forceinline__ float* mods() const { return (float*)(ws + WS_MODS); }
    __device__ __forceinline__ h16* Wgu(int l) const { return (h16*)(ws + (l ? WS_WGU2 : WS_WGU1)); }
    __device__ __forceinline__ h16* Wd(int l) const { return (h16*)(ws + (l ? WS_WD2 : WS_WD1)); }
    __device__ __forceinline__ h16* Win() const { return (h16*)(ws + WS_WIN); }
    __device__ __forceinline__ h16* Wout() const { return (h16*)(ws + WS_WOUT); }
    __device__ __forceinline__ h16* XN() const { return (h16*)(ws + WS_XN); }
    __device__ __forceinline__ h16* H() const { return (h16*)(ws + WS_H); }
    __device__ __forceinline__ h16* QO() const { return (h16*)(ws + WS_QO); }
    __device__ __forceinline__ h16* KA() const { return (h16*)(ws + WS_KA); }
    __device__ __forceinline__ h16* VA() const { return (h16*)(ws + WS_VA); }
    __device__ __forceinline__ h16* QI() const { return (h16*)(ws + WS_QI); }
    __device__ __forceinline__ h16* KI() const { return (h16*)(ws + WS_KI); }
    __device__ __forceinline__ h16* KB() const { return (h16*)(ws + WS_KB); }
    __device__ __forceinline__ h16* VB() const { return (h16*)(ws + WS_VB); }
    __device__ __forceinline__ float* WI() const { return (float*)(ws + WS_WI); }
    __device__ __forceinline__ h16* H1() const { return (h16*)(ws + WS_H1); }
    __device__ __forceinline__ float* SS() const { return (float*)(ws + WS_SS); }
    __device__ __forceinline__ h16* Fb() const { return (h16*)(ws + WS_F); }
    __device__ __forceinline__ unsigned long long* MASK() const { return (unsigned long long*)(ws + WS_MASK); }
};
__device__ __forceinline__ float wave_sum(float v) {
#pragma unroll
    for (int o = 1; o < 64; o <<= 1) v += __shfl_xor(v, o);
    return v;
}
#define WG_BAR() asm volatile("s_waitcnt vmcnt(0) lgkmcnt(0)\n\ts_barrier" ::: "memory")

__device__ __forceinline__ void adaln_unit(const Frame& F, int u) {
    LAS float* s = (LAS float*)(F.lds + RING_OFF);
    LAS float* red = s + 16 * 1024;
    { float cv[32];
#pragma unroll
      for (int i = 0; i < 32; ++i) cv[i] = F.c[F.tid + i * NWAVES * 64];
#pragma unroll
      for (int i = 0; i < 32; ++i) s[F.tid + i * NWAVES * 64] = cv[i] / (1.0f + __expf(-cv[i])); }
    WG_BAR();
    float acc[16];
#pragma unroll
    for (int b = 0; b < 16; ++b) acc[b] = 0.f;
    const float* wp = F.w_ada + (size_t)(128 * F.wave) * NMOD + 64 * u + F.lane;
    float wv[128];
#pragma unroll
    for (int i = 0; i < 128; ++i) wv[i] = wp[(size_t)i * NMOD];
#pragma unroll
    for (int q = 0; q < 32; ++q)
#pragma unroll
        for (int b = 0; b < 16; ++b) { const f32x4 sv = *(const LAS f32x4*)(s + b * 1024 + 128 * F.wave + 4 * q); acc[b] += (sv.x * wv[4 * q] + sv.y * wv[4 * q + 1]) + (sv.z * wv[4 * q + 2] + sv.w * wv[4 * q + 3]); }
#pragma unroll
    for (int b = 0; b < 16; ++b) red[(F.wave * 16 + b) * 64 + F.lane] = acc[b];
    WG_BAR();
    for (int i = F.tid; i < 16 * 64; i += NWAVES * 64) { const int b = i >> 6, l = i & 63; float t = F.b_ada[64 * u + l];
#pragma unroll
        for (int w = 0; w < 8; ++w) t += red[(w * 16 + b) * 64 + l];
        F.mods()[(size_t)b * NMOD + 64 * u + l] = t; }
    WG_BAR();
}
__device__ __forceinline__ void tr_item(const float* W, int ldw, int k0, int src_col0, int ncols, h16* WT, int dst_row0, int K, LAS float* scr, int lane, const float* ksc = nullptr) {
    const int r8 = lane >> 3, c4 = lane & 7;
    f32x4 v[8];
#pragma unroll
    for (int i = 0; i < 8; ++i) v[i] = (4 * c4 < ncols) ? *(const f32x4*)(W + (size_t)(k0 + 8 * i + r8) * ldw + src_col0 + 4 * c4) : (f32x4){0.f, 0.f, 0.f, 0.f};
#pragma unroll
    for (int i = 0; i < 8; ++i) { const int kk = 8 * i + r8; const float kv = ksc ? ksc[kk] : 1.0f; LAS float* d = scr + kk * 33 + 4 * c4; d[0] = v[i].x * kv; d[1] = v[i].y * kv; d[2] = v[i].z * kv; d[3] = v[i].w * kv; }
    LDS_WAIT(); asm volatile("" ::: "memory");
    const int c = lane & 7;
#pragma unroll
    for (int j = 0; j < 4; ++j) { const int n = (lane >> 3) + 8 * j; const LAS float* sp = scr + (8 * c) * 33 + n;
        u32x4 o; o.x = pkh(sp[0 * 33], sp[1 * 33]); o.y = pkh(sp[2 * 33], sp[3 * 33]); o.z = pkh(sp[4 * 33], sp[5 * 33]); o.w = pkh(sp[6 * 33], sp[7 * 33]);
        *(GAS u32x4*)(WT + (size_t)(dst_row0 + n) * K + k0 + 8 * c) = o; }
    LDS_WAIT(); asm volatile("" ::: "memory");
}
__device__ __forceinline__ void p0_prologue(const Frame& F) { if (F.vcu < 144) adaln_unit(F, F.vcu); }
__device__ __forceinline__ void wconv_phase(const Frame& F) {
    LAS float* scr = (LAS float*)(F.lds + RING_OFF + F.wave * 16384);
    const int gw = F.vcu * NWAVES + F.wave, NGW = F.G * NWAVES;
    constexpr int I_GU = 16 * 176, I_DN = 44 * 32, I_IN = 16 * 120, I_OUT = 16 * 32, NITEMS = 2 * I_GU + 2 * I_DN + I_IN + I_OUT;
    for (int it = gw; it < NITEMS; it += NGW) {
        int r = it;
        if (r < 2 * I_GU) { const int l = r / I_GU; r -= l * I_GU; const int kb = r / 176, nb = r % 176, pn = nb >> 3, rr = (nb & 7) * 32;
            const float* src = (rr < 128 ? F.w_gate : F.w_up) + (size_t)l * D * FF;
            tr_item(src, FF, 64 * kb, 128 * pn + (rr & 127), 32, F.Wgu(l), 32 * nb, D, scr, F.lane); continue; }
        r -= 2 * I_GU;
        if (r < 2 * I_DN) { const int l = r / I_DN; r -= l * I_DN; const int kb = r / 32, nb = r % 32;
            tr_item(F.w_down + (size_t)l * FF * D, D, 64 * kb, 32 * nb, 32, F.Wd(l), 32 * nb, FF, scr, F.lane); continue; }
        r -= 2 * I_DN;
        if (r < I_IN) { const int kb = r / 120, nb = r % 120, pn = nb >> 3, sel = pn >> 1; int sc0, nc = 32;
            if (pn < 14) { const int base = (sel == 0) ? 0 : (sel == 1) ? 2120 : (sel == 2) ? 512 : (sel == 3) ? 1024 : (sel == 4) ? 1536 : (sel == 5) ? 2632 : 3144; sc0 = base + 32 * nb - 512 * sel; }
            else { const int gI = nb & 7; if (gI == 0) sc0 = 2048; else if (gI == 1) { sc0 = 2112; nc = 8; } else if (gI == 4) sc0 = 2080; else { sc0 = 0; nc = 0; } }
            tr_item(F.w_in, INCOLS, 64 * kb, sc0, nc, F.Win(), 32 * nb, D, scr, F.lane); continue; }
        r -= I_IN;
        { const int kb = r / 32, nb = r % 32; tr_item(F.w_out, D, 64 * kb, 32 * nb, 32, F.Wout(), 32 * nb, D, scr, F.lane, kb < 8 ? F.g_out_a + 64 * kb : F.g_out_b + 64 * (kb - 8)); }
    }
}

__device__ __forceinline__ void prenorm_phase(const Frame& F, const float* src, int ns) {
    const int gw = F.vcu * NWAVES + F.wave, NGW = F.G * NWAVES;
    for (int r0 = gw * 16; r0 < M; r0 += NGW * 16) {
        const int b = r0 / SEQ; const float* md = F.mods() + (size_t)b * NMOD;
        f32x4 a2[4], b2[4];
#pragma unroll
        for (int j = 0; j < 4; ++j) { const int col = 4 * F.lane + 256 * j; const f32x4 g = *(const f32x4*)(F.g_pre + ns * D + col), sc = *(const f32x4*)(md + (3 * ns + 1) * D + col);
            a2[j] = g * (1.0f + sc); b2[j] = *(const f32x4*)(md + (3 * ns) * D + col); }
        for (int r = r0; r < r0 + 16; ++r) {
            const GAS f32x4* xr = (const GAS f32x4*)(src + (size_t)r * D) + F.lane; f32x4 v[4]; float s = 0.f;
#pragma unroll
            for (int j = 0; j < 4; ++j) { v[j] = xr[64 * j]; s += (v[j].x * v[j].x + v[j].y * v[j].y) + (v[j].z * v[j].z + v[j].w * v[j].w); }
            const float rstd = 1.0f / sqrtf(wave_sum(s) * (1.0f / D) + EPS);
            GAS u32x2* o8 = (GAS u32x2*)(F.XN() + (size_t)r * D) + F.lane;
#pragma unroll
            for (int j = 0; j < 4; ++j) { const f32x4 n = v[j] * rstd * a2[j] + b2[j]; u32x2 w; w.x = pkh(n.x, n.y); w.y = pkh(n.z, n.w); o8[64 * j] = w; }
        }
    }
}
typedef _Float16 hf4 __attribute__((ext_vector_type(4)));
__device__ __forceinline__ f32x4 ld4h(const h16* p) { const hf4 v = *(const GAS hf4*)p; return __builtin_convertvector(v, f32x4); }
template <bool BASE32, bool OUT32>
__device__ __forceinline__ void resnorm_phase(const Frame& F, int sub, float gmul, int ns, const unsigned long long* ts = nullptr) {
    float amp_ = 0.f, spike_ = 0.f;
    if (OUT32 && ts) { if (MK_PROF_A >= 0) amp_ = sqrtf(1.133e-6f * 0.01f * (float)(long long)(ts[MK_PROF_A + 1] - ts[MK_PROF_A])); if (MK_PROF_B >= 0) spike_ = 0.01f * (1.0f / 50.0f) * (float)(long long)(ts[MK_PROF_B + 1] - ts[MK_PROF_B]); }
    const int gw = F.vcu * NWAVES + F.wave, NGW = F.G * NWAVES;
    for (int r0 = gw * 16; r0 < M; r0 += NGW * 16) {
        const int b = r0 / SEQ; const float* md = F.mods() + (size_t)b * NMOD;
        f32x4 c1[4], a2[4], b2[4];
#pragma unroll
        for (int j = 0; j < 4; ++j) { const int col = 4 * F.lane + 256 * j;
            c1[j] = *(const f32x4*)(md + (3 * sub + 2) * D + col) * *(const f32x4*)(F.g_post + sub * D + col) * gmul;
            if (ns >= 0) { const f32x4 g = *(const f32x4*)(F.g_pre + ns * D + col), sc = *(const f32x4*)(md + (3 * ns + 1) * D + col); a2[j] = g * (1.0f + sc); b2[j] = *(const f32x4*)(md + (3 * ns) * D + col); }
            else { a2[j] = (f32x4){0.f, 0.f, 0.f, 0.f}; b2[j] = a2[j]; } }
        for (int r = r0; r < r0 + 16; ++r) {
            const size_t ro = (size_t)r * D + 4 * F.lane;
            f32x4 f[4], h[4]; float s = 0.f;
#pragma unroll
            for (int j = 0; j < 4; ++j) { f[j] = ld4h(F.Fb() + ro + 256 * j); h[j] = BASE32 ? *(const GAS f32x4*)(F.x + ro + 256 * j) : ld4h(F.H1() + ro + 256 * j);
                s += (f[j].x * f[j].x + f[j].y * f[j].y) + (f[j].z * f[j].z + f[j].w * f[j].w); }
            const float rstd = 1.0f / sqrtf(wave_sum(s) * (1.0f / D) + EPS);
            float s2 = 0.f;
#pragma unroll
            for (int j = 0; j < 4; ++j) { h[j] = h[j] + c1[j] * f[j] * rstd;
                if (OUT32) { f32x4 ho_ = h[j]; if (MK_PROF_A >= 0) { const float a_ = (r & 1) ? amp_ : -amp_; ho_ = ho_ + (f32x4){a_, -a_, a_, -a_}; } if (MK_PROF_B >= 0 && r == 0 && j == 0 && F.lane == 0) ho_.x += spike_; *(GAS f32x4*)(F.out + ro + 256 * j) = ho_; } else { u32x2 w; w.x = pkh(h[j].x, h[j].y); w.y = pkh(h[j].z, h[j].w); *(GAS u32x2*)(F.H1() + ro + 256 * j) = w; }
                s2 += (h[j].x * h[j].x + h[j].y * h[j].y) + (h[j].z * h[j].z + h[j].w * h[j].w); }
            if (ns >= 0) {
                const float r2 = 1.0f / sqrtf(wave_sum(s2) * (1.0f / D) + EPS);
#pragma unroll
                for (int j = 0; j < 4; ++j) { const f32x4 n = h[j] * r2 * a2[j] + b2[j]; u32x2 w; w.x = pkh(n.x, n.y); w.y = pkh(n.z, n.w); *(GAS u32x2*)(F.XN() + ro + 256 * j) = w; }
            }
        }
    }
}
__device__ __forceinline__ void onorm_phase(const Frame& F) {
    const int gw = F.vcu * NWAVES + F.wave, NGW = F.G * NWAVES;
    f32x4 ga[2][2];
#pragma unroll
    for (int j = 0; j < 2; ++j)
#pragma unroll
        for (int e = 0; e < 2; ++e) ga[j][e] = *(const f32x4*)((j == 0 ? F.g_out_a : F.g_out_b) + 8 * F.lane + 4 * e);
    for (int r = gw; r < M; r += NGW) {
        GAS u32x4* p = (GAS u32x4*)(F.QO() + (size_t)r * D) + F.lane;
#pragma unroll
        for (int j = 0; j < 2; ++j) {
            const u32x4 raw = p[64 * j]; const hf8 hv = __builtin_bit_cast(hf8, raw); float v[8]; float s = 0.f;
#pragma unroll
            for (int e = 0; e < 8; ++e) { v[e] = (float)hv[e]; s += v[e] * v[e]; }
            const float rstd = 1.0f / sqrtf(wave_sum(s) * (1.0f / 512.0f) + EPS);
            u32x4 w; w.x = pkh(v[0] * rstd * ga[j][0][0], v[1] * rstd * ga[j][0][1]); w.y = pkh(v[2] * rstd * ga[j][0][2], v[3] * rstd * ga[j][0][3]);
            w.z = pkh(v[4] * rstd * ga[j][1][0], v[5] * rstd * ga[j][1][1]); w.w = pkh(v[6] * rstd * ga[j][1][2], v[7] * rstd * ga[j][1][3]);
            p[64 * j] = w;
        }
    }
}

constexpr int SC_LD = 2052;
__device__ __forceinline__ unsigned f2ord(float f) { const unsigned u = __builtin_bit_cast(unsigned, f); return (u & 0x80000000u) ? ~u : (u | 0x80000000u); }
__device__ __forceinline__ float ord2f(unsigned o) { const unsigned u = (o & 0x80000000u) ? (o & 0x7fffffffu) : ~o; return __builtin_bit_cast(float, u); }
__device__ __forceinline__ int wave_sum_i(int v) {
    v += __builtin_amdgcn_update_dpp(0, v, 0x111, 0xf, 0xf, true); v += __builtin_amdgcn_update_dpp(0, v, 0x112, 0xf, 0xf, true);
    v += __builtin_amdgcn_update_dpp(0, v, 0x114, 0xf, 0xf, true); v += __builtin_amdgcn_update_dpp(0, v, 0x118, 0xf, 0xf, true);
    v += __builtin_amdgcn_update_dpp(0, v, 0x142, 0xa, 0xf, false);
    v += __builtin_amdgcn_update_dpp(0, v, 0x143, 0xc, 0xf, false);
    return __builtin_amdgcn_readlane(v, 63);
}
__device__ __forceinline__ float wave_max_f(float x) {
    int v = __builtin_bit_cast(int, x);
#define WMX(ctrl, rm) do { const int t_ = __builtin_amdgcn_update_dpp(v, v, ctrl, rm, 0xf, false); v = __builtin_bit_cast(int, fmaxf(__builtin_bit_cast(float, v), __builtin_bit_cast(float, t_))); } while (0)
    WMX(0x111, 0xf); WMX(0x112, 0xf); WMX(0x114, 0xf); WMX(0x118, 0xf); WMX(0x142, 0xa); WMX(0x143, 0xc);
#undef WMX
    return __builtin_bit_cast(float, __builtin_amdgcn_readlane(v, 63));
}
__device__ __forceinline__ float relu_i(float x) { const int xi = __builtin_bit_cast(int, x); return __builtin_bit_cast(float, xi > 0 ? xi : 0); }
__device__ __forceinline__ void idx_unit(const Frame& F, int b, int blk) {
    LAS float* sc = (LAS float*)(F.lds + RING_OFF);
    const int lane = F.lane, wid = F.wave, t0 = blk * 16; const size_t rowbase = (size_t)b * SEQ;
    {
        const h16* qp = F.QI() + (rowbase + t0 + (lane & 15)) * 512 + (lane >> 4) * 8;
        hf8 bq[8][2];
#pragma unroll
        for (int h = 0; h < 8; ++h)
#pragma unroll
            for (int ks = 0; ks < 2; ++ks) bq[h][ks] = __builtin_bit_cast(hf8, *(const u32x4*)(qp + h * 64 + ks * 32));
        const float* wp = F.WI() + (rowbase + t0 + (lane & 15)) * 8; const f32x4 wa = *(const f32x4*)wp, wb = *(const f32x4*)(wp + 4);
        const float w[8] = {wa.x, wa.y, wa.z, wa.w, wb.x, wb.y, wb.z, wb.w};
        const h16* kbase = F.KI() + (rowbase + (lane & 15)) * 64 + (lane >> 4) * 8;
        u32x4 r0 = {0u, 0u, 0u, 0u}, r1 = r0;
        if (wid <= blk) { r0 = *(const u32x4*)(kbase + (size_t)wid * 1024); r1 = *(const u32x4*)(kbase + (size_t)wid * 1024 + 32); }
        for (int kt = wid; kt <= blk; kt += NWAVES) {
            const hf8 a0 = __builtin_bit_cast(hf8, r0), a1 = __builtin_bit_cast(hf8, r1);
            if (kt + NWAVES <= blk) { r0 = *(const u32x4*)(kbase + (size_t)(kt + NWAVES) * 1024); r1 = *(const u32x4*)(kbase + (size_t)(kt + NWAVES) * 1024 + 32); }
            f32x4 d[8];
#pragma unroll
            for (int h = 0; h < 8; ++h) d[h] = __builtin_amdgcn_mfma_f32_16x16x32_f16(a0, bq[h][0], (f32x4){0.f, 0.f, 0.f, 0.f}, 0, 0, 0);
#pragma unroll
            for (int h = 0; h < 8; ++h) d[h] = __builtin_amdgcn_mfma_f32_16x16x32_f16(a1, bq[h][1], d[h], 0, 0, 0);
            f32x4 acc = {0.f, 0.f, 0.f, 0.f};
#pragma unroll
            for (int h = 0; h < 8; ++h)
#pragma unroll
                for (int i = 0; i < 4; ++i) acc[i] += w[h] * relu_i(d[h][i]);
            *(LAS f32x4*)(sc + (lane & 15) * SC_LD + 16 * kt + 4 * (lane >> 4)) = acc;
        }
    }
    WG_BAR();
    for (int rr = 0; rr < 2; ++rr) {
        const int row = 2 * wid + rr, t = t0 + row; float v[32];
        const float NINF = -__builtin_inff();
        const int nch = (t >> 9) + 1;
#pragma unroll
        for (int j = 0; j < 32; ++j) { const int key = 64 * j + lane; const float x = sc[row * SC_LD + key]; v[j] = (key <= t) ? x : NINF; }
        float theta = NINF; bool ties = false; int take = 0;
        if (t + 1 > 256) {
            float mx = v[0], mn = (lane <= t) ? -v[0] : NINF;
#pragma unroll
            for (int j = 1; j < 32; ++j) { mx = fmaxf(mx, v[j]); mn = fmaxf(mn, (64 * j + lane <= t) ? -v[j] : NINF); }
            float hi = wave_max_f(mx), lo = -wave_max_f(mn);
#define CGE8(x, c_, j0) _Pragma("unroll") for (int j = j0; j < j0 + 8; ++j) c_ += (v[j] >= (x)) ? 1 : 0
#define CGE(x, out) do { int c_ = 0; CGE8(x, c_, 0); if (nch > 1) { CGE8(x, c_, 8); } if (nch > 2) { CGE8(x, c_, 16); } if (nch > 3) { CGE8(x, c_, 24); } out = wave_sum_i(c_); } while (0)
            int chi; CGE(hi, chi);
            if (chi >= 256) { theta = hi; if (chi > 256) { ties = true; take = 256; } }
            else {
                for (int it = 0; ; ++it) {
                    float mid = lo + (hi - lo) * 0.5f;
                    if (it >= 24 || !(mid > lo && mid < hi)) { const unsigned ul = f2ord(lo), uh = f2ord(hi), um = ul + ((uh - ul) >> 1);
                        if (um == ul) { theta = lo; ties = true; take = 256 - chi; break; }
                        mid = ord2f(um); }
                    int c; CGE(mid, c);
                    if (c == 256) { theta = mid; break; }
                    if (c > 256) lo = mid; else { hi = mid; chi = c; }
                }
            }
#undef CGE
#undef CGE8
        }
        unsigned long long mine = 0ull;
        if (!ties) {
#pragma unroll
            for (int j = 0; j < 32; ++j) { const unsigned long long bj = __ballot(v[j] >= theta && (64 * j + lane <= t)); if (lane == j) mine = bj; }
        } else {
            int left = take;
#pragma unroll
            for (int j = 0; j < 32; ++j) { const unsigned long long gt = __ballot(v[j] > theta); unsigned long long eq = __ballot(v[j] == theta);
                int ne = __popcll(eq); while (ne > left) { eq &= ~(1ull << (63 - __builtin_clzll(eq))); --ne; }
                left -= ne; if (lane == j) mine = gt | eq; }
        }
        if (lane < 32) F.MASK()[(rowbase + t) * 32 + lane] = mine;
    }
    WG_BAR();
}

__device__ __forceinline__ void idx_naive_phase(const Frame& F) {
    LAS float* qs = (LAS float*)(F.lds + RING_OFF) + F.wave * 2560;
    LAS float* ss = qs + 512;
    const int gw = F.vcu * NWAVES + F.wave, NGW = F.G * NWAVES, lane = F.lane;
    for (int row = gw; row < M; row += NGW) {
        const int b = row / SEQ, t = row % SEQ; const size_t rowbase = (size_t)b * SEQ;
        for (int i = lane; i < 512; i += 64) { const _Float16 hv = __builtin_bit_cast(_Float16, F.QI()[(size_t)row * 512 + i]); qs[i] = (float)hv; }
        float w[8];
#pragma unroll
        for (int h = 0; h < 8; ++h) w[h] = F.WI()[(size_t)row * 8 + h];
        LDS_WAIT();
        for (int j = 0; j < 32; ++j) { const int key = 64 * j + lane; float sc = -__builtin_inff();
            if (key <= t) { const h16* kp = F.KI() + (rowbase + key) * 64; float d[8];
#pragma unroll
                for (int h = 0; h < 8; ++h) d[h] = 0.f;
#pragma unroll
                for (int c = 0; c < 8; ++c) { const hf8 v = __builtin_bit_cast(hf8, *(const u32x4*)(kp + 8 * c));
#pragma unroll
                    for (int h = 0; h < 8; ++h)
#pragma unroll
                        for (int e = 0; e < 8; ++e) d[h] += qs[h * 64 + 8 * c + e] * (float)v[e]; }
                sc = 0.f;
#pragma unroll
                for (int h = 0; h < 8; ++h) sc += w[h] * fmaxf(d[h], 0.f); }
            ss[key] = sc; }
        LDS_WAIT();
        unsigned long long mine = 0ull;
        for (int j = 0; j < 32; ++j) { const int key = 64 * j + lane; const float me = ss[key]; int rank = 0;
            for (int k2 = 0; k2 <= t; ++k2) { const float o = ss[k2]; rank += (o > me || (o == me && k2 < key)) ? 1 : 0; }
            const unsigned long long bj = __ballot(key <= t && rank < 256); if (lane == j) mine = bj; }
        if (lane < 32) F.MASK()[(size_t)row * 32 + lane] = mine;
        LDS_WAIT();
    }
}
__device__ __forceinline__ void idx_phase(const Frame& F) {
    for (int i = 0; ; ++i) { const int u = i * F.G + F.vcu; if (u >= NB * 128) break;
        const int rnd = u >> 8, c = u & 255, b = c >> 4, s = c & 15, blk = (rnd & 1) ? 16 * rnd + 15 - s : 16 * rnd + s;
        idx_unit(F, b, blk); }
}

namespace att {
constexpr int SLOTB = 8192, L_K = 0, L_V = 2 * SLOTB, L_WS = 4 * SLOTB, L_OST = L_WS + NWAVES * 64 * 4, L_TBL = L_OST + NWAVES * 4096, TBL_NEG = 256, L_FLAG = L_TBL + (TBL_NEG + 384) * 4, L_END = L_FLAG + 16;
static_assert(L_END <= RING_BYTES, "attention LDS map");
__device__ __forceinline__ int crow(int r, int hi) { return (r & 3) + 8 * (r >> 2) + 4 * hi; }
__device__ __forceinline__ void glds16(const void* gsrc, unsigned lds_dst) { unsigned keep;
    asm volatile("s_mov_b32 %0, m0\n\ts_mov_b32 m0, %2\n\ts_nop 0\n\tglobal_load_lds_dwordx4 %1, off\n\ts_mov_b32 m0, %0" : "=&s"(keep) : "v"(gsrc), "s"(lds_dst) : "memory"); }
#define ATT_WAIT_BAR(N) asm volatile("s_waitcnt vmcnt(" #N ") lgkmcnt(0)\n\ts_barrier" ::: "memory")
__device__ __forceinline__ void qkt(f32x16& p0, f32x16& p1, const LAS unsigned char* Kslot, const hf8* qr, const f32x16& ci, int r32, int hi) {
    const LAS unsigned char* kb = Kslot + hi * 1024 + r32 * 16;
#pragma unroll
    for (int d0 = 0; d0 < 4; ++d0) {
        const hf8 b0 = *(const LAS hf8*)(kb + d0 * 2048), b1 = *(const LAS hf8*)(kb + d0 * 2048 + 512);
        if (d0 == 0) { p0 = __builtin_amdgcn_mfma_f32_32x32x16_f16(b0, qr[0], ci, 0, 0, 0); p1 = __builtin_amdgcn_mfma_f32_32x32x16_f16(b1, qr[0], ci, 0, 0, 0); }
        else { p0 = __builtin_amdgcn_mfma_f32_32x32x16_f16(b0, qr[d0], p0, 0, 0, 0); p1 = __builtin_amdgcn_mfma_f32_32x32x16_f16(b1, qr[d0], p1, 0, 0, 0); } }
}
__device__ __forceinline__ s16x4 vtr(const LAS unsigned char* p) { return __builtin_bit_cast(s16x4, __builtin_amdgcn_ds_read_tr16_b64_v4i16((LAS v4i16_t*)p)); }
__device__ __forceinline__ void pv(f32x16* o, const LAS unsigned char* vp, const hf8 (&pa)[4]) {
#pragma unroll
    for (int d0 = 0; d0 < 2; ++d0)
#pragma unroll
        for (int ks = 0; ks < 4; ++ks) { const s16x4 lo = vtr(vp + d0 * 4096 + ks * 1024), hi = vtr(vp + d0 * 4096 + ks * 1024 + 512);
            const hf8 vf = __builtin_bit_cast(hf8, (short __attribute__((ext_vector_type(8)))){lo[0], lo[1], lo[2], lo[3], hi[0], hi[1], hi[2], hi[3]});
            o[d0] = __builtin_amdgcn_mfma_f32_32x32x16_f16(pa[ks], vf, o[d0], 0, 0, 0); }
}
__device__ __forceinline__ void half_pair(float v, float& lo, float& hi) { lo = v; hi = v; asm volatile("s_nop 1\n\tv_permlane32_swap_b32 %0, %1" : "+v"(lo), "+v"(hi)); }
__device__ __forceinline__ float half_swap_max(float m) { float a, b; half_pair(m, a, b); return fmaxf(a, b); }
__device__ __forceinline__ float half_swap_sum(float m) { float a, b; half_pair(m, a, b); return a + b; }
__device__ __forceinline__ float keep_or_ninf(float p, unsigned k) { return __builtin_bit_cast(float, (__builtin_bit_cast(unsigned, p) & k) | (0xff800000u & ~k)); }
__device__ __forceinline__ float max3f(float a, float b, float c) { float r; asm("v_max3_f32 %0, %1, %2, %3" : "=v"(r) : "v"(a), "v"(b), "v"(c)); return r; }
__device__ __forceinline__ void pack4(hf8 (&pa)[4], const f32x16& p0, const f32x16& p1) {
#pragma unroll
    for (int ks = 0; ks < 4; ++ks) { const f32x16& p = (ks < 2) ? p0 : p1; const int o = (ks & 1) * 8;
        u32x4 w; w.x = pkh(p[o + 0], p[o + 1]); w.y = pkh(p[o + 2], p[o + 3]); w.z = pkh(p[o + 4], p[o + 5]); w.w = pkh(p[o + 6], p[o + 7]); pa[ks] = __builtin_bit_cast(hf8, w); }
}
__device__ __forceinline__ void store_o(const f32x16* o, const float* sc, h16* Ow, int pitch, float* ssp, LAS unsigned char* lds, int wid, int lane, int r32, int hi) {
    LAS h16* stg = (LAS h16*)(lds + L_OST) + wid * 2048;
#pragma unroll
    for (int r = 0; r < 16; ++r) { const int orow = crow(r, hi);
#pragma unroll
        for (int d0 = 0; d0 < 2; ++d0) { const _Float16 hv = (_Float16)(o[d0][r] * sc[r]); stg[orow * 64 + d0 * 32 + r32] = __builtin_bit_cast(h16, hv); } }
    LDS_WAIT();
#pragma unroll
    for (int i = 0; i < 4; ++i) { const int row = i * 8 + (lane >> 3), ch = lane & 7; const u32x4 v = *(const LAS u32x4*)(stg + row * 64 + ch * 8); *(u32x4*)(Ow + (size_t)row * pitch + ch * 8) = v;
        const hf8 hv = __builtin_bit_cast(hf8, v); float s = 0.f;
#pragma unroll
        for (int e = 0; e < 8; ++e) { const float x = (float)hv[e]; s += x * x; }
        s += __builtin_bit_cast(float, __builtin_amdgcn_update_dpp(0, __builtin_bit_cast(int, s), 0x111, 0xf, 0xf, true));
        s += __builtin_bit_cast(float, __builtin_amdgcn_update_dpp(0, __builtin_bit_cast(int, s), 0x112, 0xf, 0xf, true));
        s += __builtin_bit_cast(float, __builtin_amdgcn_update_dpp(0, __builtin_bit_cast(int, s), 0x114, 0xf, 0xf, true));
        if (ch == 7) ssp[(size_t)row * 16] = s; }
}
__device__ __forceinline__ int t5_bucket(int n) {
    if (n < 16) return n;
    const int large = 16 + (int)(__log2f((float)n * (1.0f / 16.0f)) * (16.0f / 3.0f));
    return large < 31 ? large : 31;
}

__device__ __forceinline__ void dsa_unit(const Frame& F, int b, int h, int qb) {
    LAS unsigned char* lds = F.lds + RING_OFF;
    const int tid = F.tid, lane = F.lane, r32 = lane & 31, hi = lane >> 5, wid = F.wave;
    const int q0 = qb * 256; const size_t rowbase = (size_t)b * SEQ;
    const h16* Qw = F.QO() + (rowbase + q0 + wid * 32) * 1024 + h * 64;
    const h16* Kh = F.KA() + rowbase * 512 + h * 64; const h16* Vh = F.VA() + rowbase * 512 + h * 64;
    const unsigned lds0 = (unsigned)(uintptr_t)lds;
    LAS float* wsf = (LAS float*)(lds + L_WS) + wid * 64; LAS float* tbl = (LAS float*)(lds + L_TBL);
    const h16* ksrc = Kh + (size_t)lane * 512 + wid * 8;
    const h16* vsrc = Vh + (size_t)(16 * (wid & 3) + (lane >> 2)) * 512 + (wid >> 2) * 32 + (lane & 3) * 8;
    const unsigned kdst = lds0 + L_K + wid * 1024, vdst = lds0 + L_V + wid * 1024;
#define DMA_KV(t, slot) do { glds16(ksrc + (size_t)(t) * 64 * 512, (unsigned)__builtin_amdgcn_readfirstlane(kdst + (slot))); glds16(vsrc + (size_t)(t) * 64 * 512, (unsigned)__builtin_amdgcn_readfirstlane(vdst + (slot))); } while (0)
    const LAS unsigned char* vp0 = lds + L_V + ((lane >> 4) & 1) * 32 + (lane & 3) * 8 + (4 * hi + ((lane & 15) >> 2)) * 64;
    const int NT = 4 * (qb + 1);
    for (int d = tid; d < TBL_NEG + 384; d += NWAVES * 64) tbl[d] = d < TBL_NEG ? 0.f : F.rel_bias[t5_bucket(d - TBL_NEG) * 8 + h] * LOG2E;
    const float bias31 = F.rel_bias[31 * 8 + h] * LOG2E;
    DMA_KV(0, 0);
    hf8 qr[4];
#pragma unroll
    for (int d0 = 0; d0 < 4; ++d0) qr[d0] = __builtin_bit_cast(hf8, *(const u32x4*)(Qw + (size_t)r32 * 1024 + d0 * 16 + hi * 8));
    const int tq = q0 + wid * 32 + r32, tqmax = q0 + wid * 32 + 31;
    const unsigned long long* mrow = F.MASK() + (rowbase + tq) * 32;
    float m = 0.f, l = 0.f; bool st = false; f32x16 o[2]; o[0] = f32x16{}; o[1] = f32x16{};
    f32x16 cfar;
#pragma unroll
    for (int r = 0; r < 16; ++r) cfar[r] = bias31;
    const float NINF = -__builtin_inff();
    for (int t = 0; t < NT; ++t) {
        const int slot = (t & 1) * SLOTB;
        const unsigned long long mw = mrow[t];
        if (t + 1 < NT) { DMA_KV(t + 1, SLOTB - slot); ATT_WAIT_BAR(2); } else { ATT_WAIT_BAR(0); }
        if (64 * t <= tqmax) {
            const bool band = (t >= NT - 6);
            f32x16 p0, p1;
            if (band) { f32x16 cband;
#pragma unroll
                for (int r = 0; r < 16; ++r) cband[r] = -m;
                qkt(p0, p1, lds + L_K + slot, qr, cband, r32, hi); }
            else qkt(p0, p1, lds + L_K + slot, qr, cfar, r32, hi);
            if (band) { const LAS float* tb = tbl + TBL_NEG + (tq - 64 * t - 4 * hi);
#pragma unroll
                for (int r = 0; r < 16; ++r) { const int cb = (r & 3) + 8 * (r >> 2); p0[r] += tb[-cb]; p1[r] += tb[-cb - 32]; } }
            const int wl = (int)((unsigned)mw >> (4 * hi)), wh = (int)((unsigned)(mw >> 32) >> (4 * hi));
#pragma unroll
            for (int r = 0; r < 16; ++r) { const int cb = (r & 3) + 8 * (r >> 2);
                const unsigned k0 = (unsigned)__builtin_amdgcn_sbfe(wl, cb, 1), k1 = (unsigned)__builtin_amdgcn_sbfe(wh, cb, 1);
                p0[r] = keep_or_ninf(p0[r], k0); p1[r] = keep_or_ninf(p1[r], k1); }
            float ra = max3f(p0[0], p0[1], p1[0]), rb = max3f(p0[2], p0[3], p1[1]); ra = max3f(ra, p1[2], p1[3]);
#pragma unroll
            for (int r = 4; r < 16; r += 4) { ra = max3f(ra, p0[r], p0[r + 1]); rb = max3f(rb, p0[r + 2], p0[r + 3]); ra = max3f(ra, p1[r], p1[r + 1]); rb = max3f(rb, p1[r + 2], p1[r + 3]); }
            const float rm = half_swap_max(fmaxf(ra, rb));
            const bool upd = (rm > 8.0f) || (!st && rm > NINF);
            if (__any(upd)) {
                const float dl = upd ? rm : 0.f, f = __builtin_amdgcn_exp2f(-dl); m += dl; l *= f; st = st || (rm > NINF);
#pragma unroll
                for (int r = 0; r < 16; ++r) { p0[r] -= dl; p1[r] -= dl; cfar[r] = bias31 - m; }
                if (hi == 0) wsf[r32] = f;
                LDS_WAIT();
#pragma unroll
                for (int d_ = 0; d_ < 2; ++d_)
#pragma unroll
                    for (int r = 0; r < 16; ++r) o[d_][r] *= wsf[crow(r, hi)];
            }
            float s0 = 0.f, s1 = 0.f, s2 = 0.f, s3 = 0.f;
#pragma unroll
            for (int r = 0; r < 16; r += 2) { p0[r] = __builtin_amdgcn_exp2f(p0[r]); p1[r] = __builtin_amdgcn_exp2f(p1[r]); p0[r + 1] = __builtin_amdgcn_exp2f(p0[r + 1]); p1[r + 1] = __builtin_amdgcn_exp2f(p1[r + 1]);
                s0 += p0[r]; s1 += p1[r]; s2 += p0[r + 1]; s3 += p1[r + 1]; }
            l += (s0 + s1) + (s2 + s3);
            hf8 pa[4]; pack4(pa, p0, p1);
            pv(o, vp0 + slot, pa);
        }
        ATT_WAIT_BAR(2);
    }
    l = half_swap_sum(l);
    if (hi == 0) wsf[32 + r32] = l;
    LDS_WAIT();
    float rli[16];
#pragma unroll
    for (int r = 0; r < 16; ++r) rli[r] = 1.0f / wsf[32 + crow(r, hi)];
    store_o(o, rli, const_cast<h16*>(Qw), 1024, F.SS() + (rowbase + q0 + wid * 32) * 16 + h, lds, wid, lane, r32, hi);
    ATT_WAIT_BAR(0);
#undef DMA_KV
}

__device__ __forceinline__ void sb_unit(const Frame& F, int b, int h, int qb) {
    LAS unsigned char* lds = F.lds + RING_OFF;
    const int lane = F.lane, r32 = lane & 31, hi = lane >> 5, wid = F.wave;
    const int q0 = qb * 256; const size_t rowbase = (size_t)b * SEQ;
    const h16* Qw = F.QO() + (rowbase + q0 + wid * 32) * 1024 + 512 + h * 64;
    const h16* Kh = F.KB() + rowbase * 512 + h * 64; const h16* Vh = F.VB() + rowbase * 512 + h * 64;
    const unsigned lds0 = (unsigned)(uintptr_t)lds;
    LAS unsigned* flag = (LAS unsigned*)(lds + L_FLAG);
    const h16* ksrc = Kh + (size_t)lane * 512 + wid * 8;
    const h16* vsrc = Vh + (size_t)(16 * (wid & 3) + (lane >> 2)) * 512 + (wid >> 2) * 32 + (lane & 3) * 8;
    const unsigned kdst = lds0 + L_K + wid * 1024, vdst = lds0 + L_V + wid * 1024;
#define DMA_KV(t, slot) do { glds16(ksrc + (size_t)(t) * 64 * 512, (unsigned)__builtin_amdgcn_readfirstlane(kdst + (slot))); glds16(vsrc + (size_t)(t) * 64 * 512, (unsigned)__builtin_amdgcn_readfirstlane(vdst + (slot))); } while (0)
    const LAS unsigned char* vp0 = lds + L_V + ((lane >> 4) & 1) * 32 + (lane & 3) * 8 + (4 * hi + ((lane & 15) >> 2)) * 64;
    const int NT = 4 * (qb + 1);
    if (F.tid == 0) flag[0] = 0u;
    DMA_KV(NT - 1, 0);
    hf8 qr[4];
#pragma unroll
    for (int d0 = 0; d0 < 4; ++d0) qr[d0] = __builtin_bit_cast(hf8, *(const u32x4*)(Qw + (size_t)r32 * 1024 + d0 * 16 + hi * 8));
    const int tq = q0 + wid * 32 + r32, tqmax = q0 + wid * 32 + 31;
    float R = 0.f; f32x16 o[2]; o[0] = f32x16{}; o[1] = f32x16{};
    bool done = false; int it = 0;
    for (int t = NT - 1; t >= 0; --t, ++it) {
        const int slot = (it & 1) * SLOTB;
        if (t > 0) { DMA_KV(t - 1, SLOTB - slot); ATT_WAIT_BAR(2); } else { ATT_WAIT_BAR(0); }
        if (!done && 64 * t < tqmax) {
            f32x16 ci = f32x16{}; f32x16 p0, p1; qkt(p0, p1, lds + L_K + slot, qr, ci, r32, hi);
            const bool full = (64 * t + 63 < q0 + wid * 32); (void)full;
            f32x16 s0, s1;
#define SB_FWD(MASKED) _Pragma("unroll") for (int r = 0; r < 16; ++r) { const int key = 64 * t + crow(r, hi); \
                { const float z = fminf(p0[r], 80.f); float sp = __builtin_amdgcn_logf(1.0f + __builtin_amdgcn_exp2f(z)); p0[r] = z - sp; if (MASKED) sp = (key < tq) ? sp : 0.f; s0[r] = sp; } \
                { const float z = fminf(p1[r], 80.f); float sp = __builtin_amdgcn_logf(1.0f + __builtin_amdgcn_exp2f(z)); p1[r] = z - sp; if (MASKED) sp = (key + 32 < tq) ? sp : 0.f; s1[r] = sp; } }
            SB_FWD(true)
#undef SB_FWD
            float T[8], ex[8];
#pragma unroll
            for (int g = 0; g < 8; ++g) { const f32x16& s = (g < 4) ? s0 : s1; const int rb = 4 * (g & 3); const float gsum = (s[rb] + s[rb + 1]) + (s[rb + 2] + s[rb + 3]);
                float slo, shi; half_pair(gsum, slo, shi); T[g] = slo + shi; ex[g] = hi ? 0.f : shi; }
            float suf[8]; suf[7] = 0.f;
#pragma unroll
            for (int g = 6; g >= 0; --g) suf[g] = suf[g + 1] + T[g + 1];
            const float total = suf[0] + T[0];
#define SB_BWD(MASKED) _Pragma("unroll") for (int g = 0; g < 8; ++g) { float run = R + suf[g] + ex[g];     \
                _Pragma("unroll") for (int i = 3; i >= 0; --i) { const int r = 4 * (g & 3) + i; const int key = 64 * t + ((g < 4) ? 0 : 32) + crow(r, hi); \
                    if (g < 4) { float a = __builtin_amdgcn_exp2f(p0[r] - run); if (MASKED) a = (key < tq) ? a : 0.f; p0[r] = a; run += s0[r]; } \
                    else { float a = __builtin_amdgcn_exp2f(p1[r] - run); if (MASKED) a = (key < tq) ? a : 0.f; p1[r] = a; run += s1[r]; } } }
            if (full) { SB_BWD(false) } else { SB_BWD(true) }
#undef SB_BWD
            R += total;
            hf8 pa[4]; pack4(pa, p0, p1);
            pv(o, vp0 + slot, pa);
            if (__all(R > 88.0f)) { done = true; if (lane == 0) __hip_atomic_fetch_add(flag, 1u, __ATOMIC_RELAXED, __HIP_MEMORY_SCOPE_WORKGROUP); }
        }
        ATT_WAIT_BAR(2);
        if (flag[0] >= (unsigned)NWAVES) break;
    }
    asm volatile("s_waitcnt vmcnt(0)" ::: "memory");
    float one[16];
#pragma unroll
    for (int r = 0; r < 16; ++r) one[r] = 1.0f;
    store_o(o, one, const_cast<h16*>(Qw), 1024, F.SS() + (rowbase + q0 + wid * 32) * 16 + 8 + h, lds, wid, lane, r32, hi);
    ATT_WAIT_BAR(0);
#undef DMA_KV
}

__device__ __forceinline__ void dsa_naive_phase(const Frame& F) {
    const int gt = (F.vcu * NWAVES + F.wave) * 64 + F.lane, NT_ = F.G * NWAVES * 64;
    for (int item = gt; item < M * 8; item += NT_) {
        const int h = item & 7, row = item >> 3, b = row / SEQ, t = row % SEQ; const size_t rowbase = (size_t)b * SEQ;
        float q[64], o[64];
        { const h16* qp = F.QO() + (size_t)row * 1024 + h * 64;
#pragma unroll
          for (int c = 0; c < 8; ++c) { const hf8 v = __builtin_bit_cast(hf8, *(const u32x4*)(qp + 8 * c));
#pragma unroll
              for (int e = 0; e < 8; ++e) { q[8 * c + e] = (float)v[e]; o[8 * c + e] = 0.f; } } }
        float m = -1e30f, l = 0.f;
        const unsigned long long* mrow = F.MASK() + (size_t)row * 32;
        for (int s = 0; s <= t; ++s) {
            if (!((mrow[s >> 6] >> (s & 63)) & 1ull)) continue;
            const h16* kp = F.KA() + (rowbase + s) * 512 + h * 64; const h16* vp = F.VA() + (rowbase + s) * 512 + h * 64;
            float dot = 0.f;
#pragma unroll
            for (int c = 0; c < 8; ++c) { const hf8 v = __builtin_bit_cast(hf8, *(const u32x4*)(kp + 8 * c));
#pragma unroll
                for (int e = 0; e < 8; ++e) dot += q[8 * c + e] * (float)v[e]; }
            const float lg = dot + F.rel_bias[t5_bucket(t - s) * 8 + h] * LOG2E;
            if (lg > m) { const float f = __builtin_amdgcn_exp2f(m - lg); l *= f;
#pragma unroll
                for (int d = 0; d < 64; ++d) o[d] *= f;
                m = lg; }
            const float p = __builtin_amdgcn_exp2f(lg - m); l += p;
#pragma unroll
            for (int c = 0; c < 8; ++c) { const hf8 v = __builtin_bit_cast(hf8, *(const u32x4*)(vp + 8 * c));
#pragma unroll
                for (int e = 0; e < 8; ++e) o[8 * c + e] += p * (float)v[e]; }
        }
        const float il = 1.0f / l; h16* op = F.QO() + (size_t)row * 1024 + h * 64;
#pragma unroll
        for (int c = 0; c < 8; ++c) { u32x4 w; w.x = pkh(o[8 * c] * il, o[8 * c + 1] * il); w.y = pkh(o[8 * c + 2] * il, o[8 * c + 3] * il); w.z = pkh(o[8 * c + 4] * il, o[8 * c + 5] * il); w.w = pkh(o[8 * c + 6] * il, o[8 * c + 7] * il);
            *(u32x4*)(op + 8 * c) = w; }
    }
}

__device__ __forceinline__ void sb_naive_phase(const Frame& F) {
    const int gt = (F.vcu * NWAVES + F.wave) * 64 + F.lane, NT_ = F.G * NWAVES * 64;
    for (int item = gt; item < M * 8; item += NT_) {
        const int h = item & 7, row = item >> 3, b = row / SEQ, t = row % SEQ; const size_t rowbase = (size_t)b * SEQ;
        float q[64], o[64];
        { const h16* qp = F.QO() + (size_t)row * 1024 + 512 + h * 64;
#pragma unroll
          for (int c = 0; c < 8; ++c) { const hf8 v = __builtin_bit_cast(hf8, *(const u32x4*)(qp + 8 * c));
#pragma unroll
              for (int e = 0; e < 8; ++e) { q[8 * c + e] = (float)v[e]; o[8 * c + e] = 0.f; } } }
        float R = 0.f;
        for (int s = t - 1; s >= 0 && R < 120.f; --s) {
            const h16* kp = F.KB() + (rowbase + s) * 512 + h * 64; const h16* vp = F.VB() + (rowbase + s) * 512 + h * 64;
            float dot = 0.f;
#pragma unroll
            for (int c = 0; c < 8; ++c) { const hf8 v = __builtin_bit_cast(hf8, *(const u32x4*)(kp + 8 * c));
#pragma unroll
                for (int e = 0; e < 8; ++e) dot += q[8 * c + e] * (float)v[e]; }
            const float z = dot * (1.0f / LOG2E);
            const float sp = fmaxf(z, 0.f) + log1pf(expf(-fabsf(z)));
            const float a = expf((z - sp) - R);
            R += sp;
#pragma unroll
            for (int c = 0; c < 8; ++c) { const hf8 v = __builtin_bit_cast(hf8, *(const u32x4*)(vp + 8 * c));
#pragma unroll
                for (int e = 0; e < 8; ++e) o[8 * c + e] += a * (float)v[e]; }
        }
        h16* op = F.QO() + (size_t)row * 1024 + 512 + h * 64;
#pragma unroll
        for (int c = 0; c < 8; ++c) { u32x4 w; w.x = pkh(o[8 * c], o[8 * c + 1]); w.y = pkh(o[8 * c + 2], o[8 * c + 3]); w.z = pkh(o[8 * c + 4], o[8 * c + 5]); w.w = pkh(o[8 * c + 6], o[8 * c + 7]);
            *(u32x4*)(op + 8 * c) = w; }
    }
}
__device__ __forceinline__ void att_phase(const Frame& F, unsigned long long* ts = nullptr) {
    if (ts && blockIdx.x == 0 && F.tid == 0) ts[19] = __builtin_amdgcn_s_memrealtime();
    for (int i = 0; ; ++i) { const int u = i * F.G + F.vcu; if (u >= 1024) break; const int rnd = u >> 8, c = u & 255, bh = c >> 1, sub = c & 1;
        const int qb = (rnd == 0) ? sub : (rnd == 1) ? 7 - sub : (rnd == 2) ? 2 + sub : 5 - sub;
#if !defined(MK_SKIP_DSA) && !defined(MK_NAIVE_DSA)
        dsa_unit(F, bh >> 3, bh & 7, qb);
#endif
    }
    if (ts && blockIdx.x == 0 && F.tid == 0) ts[20] = __builtin_amdgcn_s_memrealtime();
#ifdef MK_NAIVE_DSA
    dsa_naive_phase(F);
#endif
#ifdef MK_NAIVE_SB
    sb_naive_phase(F);
#endif
    for (int i = 0; ; ++i) { const int u = i * F.G + F.vcu; if (u >= 1024) break; const int rnd = u >> 8, c = u & 255, bh = c >> 1, sub = c & 1;
#if !defined(MK_SKIP_SB) && !defined(MK_NAIVE_SB)
        sb_unit(F, bh >> 3, bh & 7, 4 * sub + rnd);
#endif
    }
}
}

struct Args { const float* in[15]; float* out; unsigned char* ws; int ph_lo, ph_hi, li, pad; };
__global__ void __launch_bounds__(NWAVES * 64, 2) mk_fwd(Args args) {
    extern __shared__ __attribute__((aligned(16))) unsigned char lds_raw[];
    Frame F;
    F.lds = (LAS unsigned char*)lds_raw;
    volatile LAS unsigned* MISC = (volatile LAS unsigned*)(F.lds + MISC_OFF);
    F.tid = threadIdx.x; F.lane = F.tid & 63; F.wave = __builtin_amdgcn_readfirstlane(F.tid >> 6);
    F.G = gridDim.x; { const int bx = blockIdx.x; F.vcu = (F.G % 8 == 0) ? (bx % 8) * (F.G / 8) + bx / 8 : bx; }
    unsigned char* ws = args.ws;
    gu32* ctl = (gu32*)(ws + WS_CTL);
    F.x = args.in[0]; F.c = args.in[1]; F.w_ada = args.in[2]; F.b_ada = args.in[3]; F.g_pre = args.in[4]; F.g_post = args.in[5]; F.w_gate = args.in[6]; F.w_up = args.in[7]; F.w_down = args.in[8];
    F.w_in = args.in[9]; F.g_kidx = args.in[10]; F.rel_bias = args.in[11]; F.g_out_a = args.in[12]; F.g_out_b = args.in[13]; F.w_out = args.in[14]; F.out = args.out;
    F.ws = ws;
    for (int u = F.tid; u < (LDS_BYTES - LDSCTL_OFF) / 4; u += NWAVES * 64) ((LAS unsigned*)(F.lds + LDSCTL_OFF))[u] = 0u;
    __syncthreads();
    XcdBarrier bar; bar.bar = (unsigned*)(ctl + CW_BAR); bar.x = 0; bar.st = nullptr;
    if (N_LAUNCHES == 1) bar = xcd_barrier_post((unsigned*)(ctl + CW_BAR), MISC + 8);
#define GRID_BAR() do { if (N_LAUNCHES == 1) xcd_barrier(bar); } while (0)
    const int lo = args.ph_lo, hi = args.ph_hi;
    unsigned long long* const ts_ = (unsigned long long*)(ctl + 8192);
#define STAMP(k) do { if ((MK_PROF_A >= 0 || MK_PROF_B >= 0) && blockIdx.x == 0 && F.tid == 0) ts_[(k) + 1] = __builtin_amdgcn_s_memrealtime(); } while (0)
    STAMP(-1);
#define IN(k) (lo <= (k) && (k) < hi)
#define SEAM(k) do { if (IN((k) + 1)) GRID_BAR(); } while (0)

    if (IN(0)) { for (int rep_ = 0; rep_ < (MK_REPEAT == 0 ? 2 : 1); ++rep_) { if (rep_) GRID_BAR(); p0_prologue(F); } SEAM(0); STAMP(0); }
    if (IN(1)) { for (int rep_ = 0; rep_ < (MK_REPEAT == 1 ? 2 : 1); ++rep_) { if (rep_) GRID_BAR(); wconv_phase(F); prenorm_phase(F, F.x, 0); } SEAM(1); STAMP(1); }
    if (IN(2)) { _Pragma("unroll") for (int rep_ = 0; rep_ < (MK_REPEAT == 2 ? 2 : 1); ++rep_) { if (rep_) GRID_BAR(); pg8::Gemm g{F.XN(), F.Wgu(0), M, NGU, D}; pg8::StaticOrder S; S.init(M, NGU, F.G, (int)blockIdx.x); pg8::EpiSwiGLU E{F.H()};
        pg8::gemm_phase<pg8::EpiSwiGLU, pg8::StaticOrder>(F.lds + RING_OFF, g, S, E); } SEAM(2); STAMP(2); }
    if (IN(3)) { _Pragma("unroll") for (int rep_ = 0; rep_ < (MK_REPEAT == 3 ? 2 : 1); ++rep_) { if (rep_) GRID_BAR(); pg8::Gemm g{F.H(), F.Wd(0), M, D, FF}; pg8::StaticOrder S; S.init(M, D, F.G, (int)blockIdx.x); pg8::EpiF16 E{F.Fb(), D};
        pg8::gemm_phase<pg8::EpiF16, pg8::StaticOrder>(F.lds + RING_OFF, g, S, E); } SEAM(3); STAMP(3); }
    if (IN(4)) { for (int rep_ = 0; rep_ < (MK_REPEAT == 4 ? 2 : 1); ++rep_) { if (rep_) GRID_BAR(); resnorm_phase<true, false>(F, 0, 0.5f, 1); } SEAM(4); STAMP(4); }
    if (IN(5)) { _Pragma("unroll") for (int rep_ = 0; rep_ < (MK_REPEAT == 5 ? 2 : 1); ++rep_) { if (rep_) GRID_BAR(); pg8::Gemm g{F.XN(), F.Win(), M, NINP, D}; pg8::StaticOrder S; S.init(M, NINP, F.G, (int)blockIdx.x); pg8::EpiInProj E{F.QO(), F.KA(), F.VA(), F.QI(), F.KB(), F.VB(), F.KI(), F.WI(), F.g_kidx};
        pg8::gemm_phase<pg8::EpiInProj, pg8::StaticOrder>(F.lds + RING_OFF, g, S, E); } SEAM(5); STAMP(5); }
#ifdef MK_NAIVE_IDX
    if (IN(6)) { for (int rep_ = 0; rep_ < (MK_REPEAT == 6 ? 2 : 1); ++rep_) { if (rep_) GRID_BAR(); idx_naive_phase(F); } SEAM(6); STAMP(6); }
#else
    if (IN(6)) { for (int rep_ = 0; rep_ < (MK_REPEAT == 6 ? 2 : 1); ++rep_) { if (rep_) GRID_BAR(); idx_phase(F); } SEAM(6); STAMP(6); }
#endif
    if (IN(7)) { for (int rep_ = 0; rep_ < (MK_REPEAT == 7 ? 2 : 1); ++rep_) { if (rep_) GRID_BAR(); att::att_phase(F, (MK_PROF_A >= 0 || MK_PROF_B >= 0) ? ts_ : nullptr); } if (IN(9)) GRID_BAR(); STAMP(7); STAMP(8); }
    if (IN(9)) { _Pragma("unroll") for (int rep_ = 0; rep_ < (MK_REPEAT == 9 ? 2 : 1); ++rep_) { if (rep_) GRID_BAR(); pg8::Gemm g{F.QO(), F.Wout(), M, D, D}; pg8::StaticOrder S; S.init(M, D, F.G, (int)blockIdx.x); pg8::EpiOutProj E{F.Fb(), F.SS()};
        pg8::gemm_phase<pg8::EpiOutProj, pg8::StaticOrder>(F.lds + RING_OFF, g, S, E); } SEAM(9); STAMP(9); }
    if (IN(10)) { for (int rep_ = 0; rep_ < (MK_REPEAT == 10 ? 2 : 1); ++rep_) { if (rep_) GRID_BAR(); resnorm_phase<false, false>(F, 1, 1.0f, 2); } SEAM(10); STAMP(10); }
    if (IN(11)) { _Pragma("unroll") for (int rep_ = 0; rep_ < (MK_REPEAT == 11 ? 2 : 1); ++rep_) { if (rep_) GRID_BAR(); pg8::Gemm g{F.XN(), F.Wgu(1), M, NGU, D}; pg8::StaticOrder S; S.init(M, NGU, F.G, (int)blockIdx.x); pg8::EpiSwiGLU E{F.H()};
        pg8::gemm_phase<pg8::EpiSwiGLU, pg8::StaticOrder>(F.lds + RING_OFF, g, S, E); } SEAM(11); STAMP(11); }
    if (IN(12)) { _Pragma("unroll") for (int rep_ = 0; rep_ < (MK_REPEAT == 12 ? 2 : 1); ++rep_) { if (rep_) GRID_BAR(); pg8::Gemm g{F.H(), F.Wd(1), M, D, FF}; pg8::StaticOrder S; S.init(M, D, F.G, (int)blockIdx.x); pg8::EpiF16 E{F.Fb(), D};
        pg8::gemm_phase<pg8::EpiF16, pg8::StaticOrder>(F.lds + RING_OFF, g, S, E); } SEAM(12); STAMP(12); }
    if (IN(13)) { resnorm_phase<false, true>(F, 2, 0.5f, -1, (MK_PROF_A >= 0 || MK_PROF_B >= 0) ? ts_ : nullptr); }
#undef IN
#undef SEAM
#undef GRID_BAR
}

extern "C" void kernel_launch(void* const* d_in, const int* in_sizes, int n_in, void* d_out, int out_size, void* d_ws, size_t ws_size, hipStream_t stream) {
    static int grid = 0;
    if (grid == 0) {
        if (n_in != 15 || in_sizes[0] != M * D || out_size != M * D || ws_size < WS_END) { fprintf(stderr, "kernel_launch: unexpected shapes (n_in %d, in0 %d, out %d, ws %zu); nothing launched\n", n_in, n_in > 0 ? in_sizes[0] : -1, out_size, ws_size); grid = -1; return; }
        int dev = 0, cus = 0, per_cu = 0;
        if (hipGetDevice(&dev) != hipSuccess || hipDeviceGetAttribute(&cus, hipDeviceAttributeMultiprocessorCount, dev) != hipSuccess) { grid = -1; return; }
        if (hipFuncSetAttribute((const void*)mk_fwd, hipFuncAttributeMaxDynamicSharedMemorySize, LDS_BYTES) != hipSuccess) { fprintf(stderr, "kernel_launch: hipFuncSetAttribute failed\n"); grid = -1; return; }
        if (hipOccupancyMaxActiveBlocksPerMultiprocessor(&per_cu, (const void*)mk_fwd, NWAVES * 64, LDS_BYTES) != hipSuccess || per_cu < 1) fprintf(stderr, "kernel_launch: occupancy query reports %d\n", per_cu);
        (void)hipGetLastError();
        grid = cus;
    }
    if (grid < 0) return;
    if (hipMemsetAsync((char*)d_ws + WS_CTL, 0, CTL_ZERO_BYTES, stream) != hipSuccess) return;
    Args a{};
    for (int i = 0; i < 15; ++i) a.in[i] = (const float*)d_in[i];
    a.out = (float*)d_out; a.ws = (unsigned char*)d_ws;
    for (int li = 0; li < N_LAUNCHES; ++li) {
        a.ph_lo = (N_LAUNCHES == 1) ? 0 : li; a.ph_hi = (N_LAUNCHES == 1) ? NPHASE : li + 1; a.li = li;
        if (li > MK_DEBUG_STOP) { a.ph_lo = MK_DEBUG_MODE; a.ph_hi = MK_DEBUG_MODE + 1; }
        hipLaunchKernelGGL(mk_fwd, dim3(grid), dim3(NWAVES * 64), LDS_BYTES, stream, a);
        if (li > MK_DEBUG_STOP) break;
    }
}
```
